# Optimizing an MI355X kernel written in HIP

```python
import math
import jax, jax.numpy as jnp
from jax import lax
import numpy as np

D_MODEL = 1024
BATCH = 16
SEQ = 2048
DEPTH = 2

N_MIXERS = 2
HEAD_DIM = 64
N_HEADS = D_MODEL // HEAD_DIM
RWKV_DECAY_LORA = 64
RWKV_AAA_LORA = 64
RWKV_GATE_LORA = 128
RWKV_GN_EPS = 64e-5
MOBA_BLOCK = 256
MOBA_TOPK = 3
Q_CHUNK = 128
ROPE_THETA = 10000.0
MEM_TOKENS = 256
MEM_HEADS = 4
MEM_HEAD_DIM = D_MODEL // MEM_HEADS
MOE_GROUPS = 4
MOE_EXPERTS_PER_GROUP = 8
MOE_EXPERTS = MOE_GROUPS * MOE_EXPERTS_PER_GROUP
MOE_TOPK = 2
MOE_FF = D_MODEL // 2
MOE_ROW_BLOCK = 128
RMS_EPS = 1e-6
NEG_INF = -1e30
N_RWKV_LAYERS = (DEPTH + N_MIXERS - 1) // N_MIXERS
N_MOBA_LAYERS = DEPTH // N_MIXERS

kernel_name = "hybrid_rwkv7_moba_memxattn_hmoe"

F32 = jnp.float32


def rms_norm(x, g):
    xf = x.astype(F32)
    y = xf * lax.rsqrt(jnp.mean(xf * xf, axis=-1, keepdims=True) + RMS_EPS)
    return (y * g.astype(F32)).astype(x.dtype)


def rotary(t, positions):
    half = t.shape[-1] // 2
    inv = ROPE_THETA ** (-jnp.arange(half, dtype=F32) * 2.0 / t.shape[-1])
    ang = positions.astype(F32)[..., None] * inv
    cos = jnp.cos(ang)[:, :, None, :]
    sin = jnp.sin(ang)[:, :, None, :]
    tf = t.astype(F32)
    t1, t2 = tf[..., :half], tf[..., half:]
    return jnp.concatenate([t1 * cos - t2 * sin, t2 * cos + t1 * sin], axis=-1).astype(t.dtype)


def rwkv7_time_mix(h, mu, w0, w1, w2, a0, a1, a2, g1, g2, k_k, k_a, r_k, w_rkv, lnx_g, lnx_b, w_o):
    B, T, C = h.shape
    dx = jnp.pad(h, ((0, 0), (1, 0), (0, 0)))[:, :T] - h
    xr, xw, xk, xv, xa, xg = [h + dx * mu[s] for s in range(6)]
    r = xr @ w_rkv[0]
    k = xk @ w_rkv[1]
    v = xv @ w_rkv[2]
    w = -jax.nn.softplus(-(w0 + jnp.tanh(xw @ w1) @ w2)) - 0.5
    a = jax.nn.sigmoid(a0 + (xa @ a1) @ a2)
    g = jax.nn.sigmoid(xg @ g1) @ g2

    def heads(t):
        return t.reshape(B, T, N_HEADS, HEAD_DIM).astype(F32)

    kk = heads(k * k_k)
    kk = kk / jnp.maximum(jnp.sqrt(jnp.sum(kk * kk, axis=-1, keepdims=True)), 1e-12)
    k = k * (1.0 + (a - 1.0) * k_a)
    r_h, k_h, v_h, a_h = heads(r), heads(k), heads(v), heads(a)
    decay = jnp.exp(-jnp.exp(heads(w)))

    def step(S, inp):
        r_t, d_t, k_t, v_t, kk_t, akk_t = inp
        s_kk = jnp.einsum('bhvk,bhk->bhv', S, kk_t)
        S = S * d_t[:, :, None, :] - s_kk[..., None] * akk_t[:, :, None, :] + v_t[..., None] * k_t[:, :, None, :]
        return S, jnp.einsum('bhvk,bhk->bhv', S, r_t)

    def tm(t):
        return jnp.swapaxes(t, 0, 1)

    S0 = jnp.zeros((B, N_HEADS, HEAD_DIM, HEAD_DIM), F32)
    _, o = lax.scan(step, S0, (tm(r_h), tm(decay), tm(k_h), tm(v_h), tm(kk), tm(kk * a_h)))
    o = tm(o)
    mean = jnp.mean(o, axis=-1, keepdims=True)
    var = jnp.mean((o - mean) ** 2, axis=-1, keepdims=True)
    o = ((o - mean) * lax.rsqrt(var + RWKV_GN_EPS)).reshape(B, T, C) * lnx_g.astype(F32) + lnx_b.astype(F32)
    bonus = (jnp.sum(r_h * k_h * r_k.astype(F32), axis=-1, keepdims=True) * v_h).reshape(B, T, C)
    return ((o + bonus).astype(h.dtype) * g) @ w_o


def moba_attention(h, positions, w_qkv, w_o):
    B, T, C = h.shape
    qkv = (h @ w_qkv).reshape(B, T, 3, N_HEADS, HEAD_DIM)
    q = jnp.transpose(rotary(qkv[:, :, 0], positions), (0, 2, 1, 3))
    k = jnp.transpose(rotary(qkv[:, :, 1], positions), (0, 2, 1, 3))
    v = jnp.transpose(qkv[:, :, 2], (0, 2, 1, 3))
    n_blk = -(-T // MOBA_BLOCK)
    pad = n_blk * MOBA_BLOCK - T
    kb = jnp.pad(k, ((0, 0), (0, 0), (0, pad), (0, 0))).reshape(B, N_HEADS, n_blk, MOBA_BLOCK, HEAD_DIM)
    vb = jnp.pad(v, ((0, 0), (0, 0), (0, pad), (0, 0))).reshape(B, N_HEADS, n_blk, MOBA_BLOCK, HEAD_DIM)
    scale = 1.0 / math.sqrt(HEAD_DIM)
    topk_eff = min(MOBA_TOPK, n_blk - 1)
    q_blk = jnp.arange(T) // MOBA_BLOCK
    if topk_eff > 0:
        kmean = jnp.mean(kb.astype(F32), axis=3)
        gate = jnp.einsum('bhtd,bhnd->bhtn', q.astype(F32), kmean)
        past = jnp.arange(n_blk)[None, :] < q_blk[:, None]
        gate = jnp.where(past, gate, NEG_INF)
        _, sel = lax.top_k(gate, topk_eff)
        sel_valid = jnp.arange(topk_eff)[None, :] < q_blk[:, None]
    n_qc = T // Q_CHUNK
    h_ar = jnp.arange(N_HEADS)[:, None, None]
    q_off = jnp.arange(Q_CHUNK)
    k_off = jnp.arange(MOBA_BLOCK)

    def chunk(i):
        b = i // n_qc
        q0 = (i % n_qc) * Q_CHUNK
        qc = lax.dynamic_slice_in_dim(q[b], q0, Q_CHUNK, axis=1)
        kb_b = kb[b]
        vb_b = vb[b]
        own = q0 // MOBA_BLOCK
        k_own = lax.dynamic_index_in_dim(kb_b, own, axis=1, keepdims=False)
        v_own = lax.dynamic_index_in_dim(vb_b, own, axis=1, keepdims=False)
        s_own = jnp.einsum('hqd,hkd->hqk', qc, k_own, preferred_element_type=F32) * scale
        causal = (own * MOBA_BLOCK + k_off)[None, :] <= (q0 + q_off)[:, None]
        s_own = jnp.where(causal[None], s_own, NEG_INF)
        if topk_eff > 0:
            sel_c = lax.dynamic_slice_in_dim(sel[b], q0, Q_CHUNK, axis=1)
            valid_c = lax.dynamic_slice_in_dim(sel_valid, q0, Q_CHUNK, axis=0)
            k_sel = kb_b[h_ar, sel_c]
            v_sel = vb_b[h_ar, sel_c]
            s_sel = jnp.einsum('hqd,hqnkd->hqnk', qc, k_sel, preferred_element_type=F32) * scale
            s_sel = jnp.where(valid_c[None, :, :, None], s_sel, NEG_INF)
            s_sel = s_sel.reshape(N_HEADS, Q_CHUNK, topk_eff * MOBA_BLOCK)
            p = jax.nn.softmax(jnp.concatenate([s_sel, s_own], axis=-1), axis=-1)
            p_sel = p[..., :topk_eff * MOBA_BLOCK].reshape(N_HEADS, Q_CHUNK, topk_eff, MOBA_BLOCK).astype(v.dtype)
            p_own = p[..., topk_eff * MOBA_BLOCK:].astype(v.dtype)
            return (jnp.einsum('hqnk,hqnkd->hqd', p_sel, v_sel)
                    + jnp.einsum('hqk,hkd->hqd', p_own, v_own))
        p_own = jax.nn.softmax(s_own, axis=-1).astype(v.dtype)
        return jnp.einsum('hqk,hkd->hqd', p_own, v_own)

    outs = lax.map(chunk, jnp.arange(B * n_qc))
    o = outs.reshape(B, n_qc, N_HEADS, Q_CHUNK, HEAD_DIM).transpose(0, 1, 3, 2, 4).reshape(B, T, C)
    return o @ w_o


def mem_cross_attention(h, mem_n, w_q, w_kv, w_o):
    B, T, C = h.shape
    M = mem_n.shape[1]
    q = (h @ w_q).reshape(B, T, MEM_HEADS, MEM_HEAD_DIM)
    kv = (mem_n @ w_kv).reshape(B, M, 2, MEM_HEADS, MEM_HEAD_DIM)
    s = jnp.einsum('bthd,bmhd->bhtm', q, kv[:, :, 0], preferred_element_type=F32) / math.sqrt(MEM_HEAD_DIM)
    p = jax.nn.softmax(s, axis=-1).astype(h.dtype)
    o = jnp.einsum('bhtm,bmhd->bthd', p, kv[:, :, 1]).reshape(B, T, C)
    return o @ w_o


def hierarchical_moe(h, w_grp, b_grp, w_exp, b_exp, w1, w3, w2):
    N, C = h.shape
    R = MOE_ROW_BLOCK
    g_logits = jnp.einsum('nc,cg->ng', h, w_grp, preferred_element_type=F32) + b_grp.astype(F32)
    p_g, g_idx = lax.top_k(jax.nn.softmax(g_logits, axis=-1), 1)
    e_logits = (jnp.einsum('nc,ce->ne', h, w_exp, preferred_element_type=F32) + b_exp.astype(F32))
    e_logits = e_logits.reshape(N, MOE_GROUPS, MOE_EXPERTS_PER_GROUP)
    e_logits = jnp.take_along_axis(e_logits, g_idx[:, :, None], axis=1)[:, 0]
    p_e, e_loc = lax.top_k(jax.nn.softmax(e_logits, axis=-1), MOE_TOPK)
    gate = p_g * p_e / jnp.sum(p_e, axis=-1, keepdims=True)
    expert = g_idx * MOE_EXPERTS_PER_GROUP + e_loc

    P = N * MOE_TOPK
    flat_e = expert.reshape(-1)
    flat_tok = jnp.repeat(jnp.arange(N, dtype=jnp.int32), MOE_TOPK)
    flat_gate = gate.reshape(-1)
    order = jnp.argsort(flat_e)
    e_sorted = flat_e[order]
    counts = jnp.bincount(flat_e, length=MOE_EXPERTS)
    padded = (counts + R - 1) // R * R
    start = jnp.cumsum(counts) - counts
    pad_end = jnp.cumsum(padded)
    pad_start = pad_end - padded
    dest = pad_start[e_sorted] + (jnp.arange(P) - start[e_sorted])
    n_blocks = (P + MOE_EXPERTS * (R - 1) + R - 1) // R
    n_rows = n_blocks * R
    row_tok = jnp.zeros((n_rows,), jnp.int32).at[dest].set(flat_tok[order])
    row_gate = jnp.zeros((n_rows,), F32).at[dest].set(flat_gate[order])
    block_expert = jnp.minimum(jnp.searchsorted(pad_end, jnp.arange(n_blocks) * R, side='right'),
                               MOE_EXPERTS - 1)
    x_rows = h[row_tok].reshape(n_blocks, R, C)

    def expert_block(args):
        xb, e = args
        return (jax.nn.silu(xb @ w1[e]) * (xb @ w3[e])) @ w2[e]

    y = lax.map(expert_block, (x_rows, block_expert)).reshape(n_rows, C)
    out = jnp.zeros((N, C), F32).at[row_tok].add(y.astype(F32) * row_gate[:, None])
    return out.astype(h.dtype)


def setup_inputs(seed: int = 0) -> dict:
    key = jax.random.key(seed)
    ks = iter(jax.random.split(key, 40))
    D = D_MODEL

    def nrm(shape, scale):
        return jax.random.normal(next(ks), shape, F32) * scale

    def gain(shape):
        return 1.0 + nrm(shape, 0.05)

    NR, NM = N_RWKV_LAYERS, N_MOBA_LAYERS
    return {
        "x": nrm((BATCH, SEQ, D), 1.0),
        "mem": nrm((BATCH, MEM_TOKENS, D), 1.0),
        "positions": jnp.tile(jnp.arange(SEQ, dtype=jnp.int32)[None, :], (BATCH, 1)),
        "ln_mix": gain((DEPTH, D)),
        "ln_mem": gain((DEPTH, D)),
        "ln_memkv": gain((DEPTH, D)),
        "ln_ffn": gain((DEPTH, D)),
        "rw_mu": jax.random.uniform(next(ks), (NR, 6, D), F32),
        "rw_w0": nrm((NR, D), 0.5),
        "rw_w1": nrm((NR, D, RWKV_DECAY_LORA), D ** -0.5),
        "rw_w2": nrm((NR, RWKV_DECAY_LORA, D), 0.1 * RWKV_DECAY_LORA ** -0.5),
        "rw_a0": nrm((NR, D), 0.3),
        "rw_a1": nrm((NR, D, RWKV_AAA_LORA), D ** -0.5),
        "rw_a2": nrm((NR, RWKV_AAA_LORA, D), 0.1 * RWKV_AAA_LORA ** -0.5),
        "rw_g1": nrm((NR, D, RWKV_GATE_LORA), D ** -0.5),
        "rw_g2": nrm((NR, RWKV_GATE_LORA, D), RWKV_GATE_LORA ** -0.5),
        "rw_kk": 0.85 + nrm((NR, D), 0.05),
        "rw_ka": 1.0 + nrm((NR, D), 0.05),
        "rw_rk": nrm((NR, N_HEADS, HEAD_DIM), 0.3),
        "rw_wrkv": nrm((NR, 3, D, D), D ** -0.5),
        "rw_lnx_g": gain((NR, D)),
        "rw_lnx_b": nrm((NR, D), 0.01),
        "rw_wo": nrm((NR, D, D), D ** -0.5),
        "mb_wqkv": nrm((NM, D, 3 * D), D ** -0.5),
        "mb_wo": nrm((NM, D, D), D ** -0.5),
        "mx_wq": nrm((DEPTH, D, D), D ** -0.5),
        "mx_wkv": nrm((DEPTH, D, 2 * D), D ** -0.5),
        "mx_wo": nrm((DEPTH, D, D), D ** -0.5),
        "moe_wg": nrm((DEPTH, D, MOE_GROUPS), D ** -0.5),
        "moe_bg": nrm((DEPTH, MOE_GROUPS), 0.01),
        "moe_we": nrm((DEPTH, D, MOE_EXPERTS), D ** -0.5),
        "moe_be": nrm((DEPTH, MOE_EXPERTS), 0.01),
        "moe_w1": nrm((DEPTH, MOE_EXPERTS, D, MOE_FF), D ** -0.5),
        "moe_w3": nrm((DEPTH, MOE_EXPERTS, D, MOE_FF), D ** -0.5),
        "moe_w2": nrm((DEPTH, MOE_EXPERTS, MOE_FF, D), MOE_FF ** -0.5),
        "ln_f": gain((D,)),
    }


def reference(x, mem, positions, ln_mix, ln_mem, ln_memkv, ln_ffn,
              rw_mu, rw_w0, rw_w1, rw_w2, rw_a0, rw_a1, rw_a2, rw_g1, rw_g2, rw_kk, rw_ka, rw_rk,
              rw_wrkv, rw_lnx_g, rw_lnx_b, rw_wo,
              mb_wqkv, mb_wo,
              mx_wq, mx_wkv, mx_wo,
              moe_wg, moe_bg, moe_we, moe_be, moe_w1, moe_w3, moe_w2,
              ln_f):
    B, T, C = x.shape
    for i in range(DEPTH):
        j = i // N_MIXERS
        h = rms_norm(x, ln_mix[i])
        if i % N_MIXERS == 0:
            mixed = rwkv7_time_mix(h, rw_mu[j], rw_w0[j], rw_w1[j], rw_w2[j], rw_a0[j], rw_a1[j], rw_a2[j],
                                   rw_g1[j], rw_g2[j], rw_kk[j], rw_ka[j], rw_rk[j], rw_wrkv[j],
                                   rw_lnx_g[j], rw_lnx_b[j], rw_wo[j])
        else:
            mixed = moba_attention(h, positions, mb_wqkv[j], mb_wo[j])
        x = x + mixed
        x = x + mem_cross_attention(rms_norm(x, ln_mem[i]), rms_norm(mem, ln_memkv[i]),
                                    mx_wq[i], mx_wkv[i], mx_wo[i])
        h2 = rms_norm(x, ln_ffn[i]).reshape(B * T, C)
        x = x + hierarchical_moe(h2, moe_wg[i], moe_bg[i], moe_we[i], moe_be[i],
                                 moe_w1[i], moe_w3[i], moe_w2[i]).reshape(B, T, C)
    return rms_norm(x, ln_f)
```

```cpp
#include <hip/hip_runtime.h>
#include <hip/hip_bf16.h>
#include <cstdio>
#include <cstdint>
#include <cmath>

#define GAS __attribute__((address_space(1)))
#define LAS __attribute__((address_space(3)))
typedef unsigned short bf16;
typedef unsigned v4u __attribute__((ext_vector_type(4)));
typedef unsigned v2u __attribute__((ext_vector_type(2)));
typedef float f32x4 __attribute__((ext_vector_type(4)));
typedef float f32x2 __attribute__((ext_vector_type(2)));
typedef short bf16x8 __attribute__((ext_vector_type(8)));
typedef GAS unsigned gu32;
#define RLX_AGENT __ATOMIC_RELAXED, __HIP_MEMORY_SCOPE_AGENT
#define LDS_WAIT() asm volatile("s_waitcnt lgkmcnt(0)" ::: "memory")
#define VM_WAIT() asm volatile("s_waitcnt vmcnt(0)" ::: "memory")

constexpr int BATCH = 16, SEQ = 2048, DM = 1024, NTOK = BATCH * SEQ, NHEAD = 16, HD = 64;
constexpr int MEMT = 256, MEMH = 4, NMEM = BATCH * MEMT;
constexpr int NEXP = 32, FF = 512, NPAIR = NTOK * 2, PLCAP = 32768;
constexpr float RMS_EPS = 1e-6f, GN_EPS = 64e-5f;
constexpr int NWAVES = 8;

constexpr size_t MiB = 1u << 20;
constexpr size_t WS_CTL = 0, CTL_ZERO_BYTES = 64 * 1024;
constexpr size_t WS_WRKV = 2 * MiB;
constexpr size_t WS_WRWO = 8 * MiB;
constexpr size_t WS_WLD = 10 * MiB;
constexpr size_t WS_WLU = 11 * MiB;
constexpr size_t WS_WMBQKV = 13 * MiB;
constexpr size_t WS_WMBO = 19 * MiB;
constexpr size_t WS_WMXQ = 21 * MiB;
constexpr size_t WS_WMXK = 25 * MiB;
constexpr size_t WS_WMXV = 29 * MiB;
constexpr size_t WS_WMXO = 33 * MiB;
constexpr size_t WS_ROPE = 37 * MiB;
constexpr size_t WS_MEMN = 45 * MiB;
constexpr size_t WS_KMEM = 61 * MiB;
constexpr size_t WS_VMEM = 77 * MiB;
constexpr size_t WS_RINV = 97 * MiB + 256 * 1024;
constexpr size_t WS_SSQ = 97 * MiB + 512 * 1024;
constexpr size_t WS_PAIRLIST = 93 * MiB;
constexpr size_t WS_GATE = 97 * MiB;
constexpr size_t WS_LO = 98 * MiB;
constexpr size_t WS_ARENA = 114 * MiB;
constexpr size_t UNIT = 64 * MiB;
constexpr size_t WS_END = WS_ARENA + 7 * UNIT + 1 * MiB;
#define ARENA(i) (WS_ARENA + (size_t)(i) * UNIT)
constexpr int CW_BAR = 4096;
constexpr int CW_CNT = 8192;

constexpr int RING_OFF = 0, RING_BYTES = 131072;
constexpr int EPI_OFF = 131072;
constexpr int MISC_OFF = 163840 - 512;
constexpr int LDS_BYTES = 163840;

__device__ __forceinline__ unsigned f2bf(float f) { unsigned u = __builtin_bit_cast(unsigned, f); return (u + 0x7fffu + ((u >> 16) & 1u)) >> 16; }
__device__ __forceinline__ unsigned pk2(float lo, float hi) { return f2bf(lo) | (f2bf(hi) << 16); }
__device__ __forceinline__ float bflo(unsigned w) { return __builtin_bit_cast(float, w << 16); }
__device__ __forceinline__ float bfhi(unsigned w) { return __builtin_bit_cast(float, w & 0xffff0000u); }
__device__ __forceinline__ unsigned cvt_pk_bf16(float lo, float hi) { unsigned r; asm volatile("v_cvt_pk_bf16_f32 %0, %1, %2" : "=v"(r) : "v"(lo), "v"(hi)); return r; }
typedef __bf16 bf16x2_hw __attribute__((ext_vector_type(2)));
__device__ __forceinline__ unsigned cvt2(float lo, float hi) { const f32x2 v = {lo, hi}; const bf16x2_hw b = __builtin_convertvector(v, bf16x2_hw); return __builtin_bit_cast(unsigned, b); }
__device__ __forceinline__ float wave_sum(float v) {
#pragma unroll
    for (int o = 1; o < 64; o <<= 1) v += __shfl_xor(v, o);
    return v;
}
template <int CTRL> __device__ __forceinline__ float dppf(float v) { return __builtin_bit_cast(float, __builtin_amdgcn_update_dpp(0, __builtin_bit_cast(int, v), CTRL, 0xf, 0xf, true)); }
__device__ __forceinline__ float row16_sum(float v) { v += dppf<0xB1>(v); v += dppf<0x4E>(v); v += dppf<0x141>(v); v += dppf<0x140>(v); return v; }
__device__ __forceinline__ float sigmoidf_(float x) { return 1.0f / (1.0f + __expf(-x)); }

#define XB_TMO      128
#define XB_XCNT(j)  (256  + 64 * (j))
#define XB_XSUB(j)  (1280 + 64 * (j))
#define XB_XGEN(j)  (2304 + 64 * (j))
#define XB_TOP      3328
#define XB_TOPGEN   3392
#define XCD_BAR_WORDS 3456
#define XB_SPIN_CAP (1u << 18)
__device__ __forceinline__ unsigned xb_ld(unsigned* p)              { return __hip_atomic_load(p, __ATOMIC_RELAXED, __HIP_MEMORY_SCOPE_AGENT); }
__device__ __forceinline__ unsigned xb_add(unsigned* p, unsigned v) { return __hip_atomic_fetch_add(p, v, __ATOMIC_RELAXED, __HIP_MEMORY_SCOPE_AGENT); }
__device__ __forceinline__ unsigned xb_xcc_id() { return (unsigned)__builtin_amdgcn_s_getreg((3 << 11) | 20) & 0xFu; }
#define XB_SPIN(cond, bar) do { unsigned _sp = 0; while (cond) { __builtin_amdgcn_s_sleep(1); \
    if ((++_sp & 255u) == 0u) { if (xb_ld(&(bar)[XB_TMO])) break; if (_sp > XB_SPIN_CAP) { atomicAdd(&(bar)[XB_TMO], 1u); break; } } } } while (0)
struct XcdBarrier { unsigned* bar; unsigned x; volatile LAS unsigned* st; };
__device__ __forceinline__ XcdBarrier xcd_barrier_post(unsigned* bar, volatile LAS unsigned* st) {
    XcdBarrier b; b.bar = bar; b.x = xb_xcc_id(); b.st = st;
    if (threadIdx.x == 0) (void)xb_add(&bar[XB_XCNT(b.x)], 1u);
    return b;
}
__device__ __forceinline__ void xcd_barrier_complete(unsigned* bar, unsigned x, unsigned& nloc, unsigned& nx) {
    const unsigned G = gridDim.x * gridDim.y * gridDim.z;
    unsigned sum, cnt, mine, sp = 0u;
    for (;;) {
        sum = 0u; cnt = 0u; mine = 0u;
#pragma unroll
        for (unsigned j = 0; j < 16; ++j) { const unsigned c = xb_ld(&bar[XB_XCNT(j)]); sum += c; cnt += (c > 0u) ? 1u : 0u; mine = (j == x) ? c : mine; }
        if (sum == G) break;
        __builtin_amdgcn_s_sleep(1);
        if ((++sp & 255u) == 0u) { if (xb_ld(&bar[XB_TMO])) break; if (sp > XB_SPIN_CAP) { atomicAdd(&bar[XB_TMO], 1u); break; } }
    }
    nloc = mine > 0u ? mine : 1u; nx = cnt > 0u ? cnt : 1u;
}
__device__ __forceinline__ void xcd_barrier(const XcdBarrier& b) {
    asm volatile("s_waitcnt vmcnt(0)" ::: "memory");
    __syncthreads();
    if (threadIdx.x == 0) {
        unsigned* bar = b.bar;
        __builtin_amdgcn_s_waitcnt(0);
        unsigned nloc = b.st[0], nx = b.st[1];
        if (nloc == 0u) { xcd_barrier_complete(bar, b.x, nloc, nx); b.st[0] = nloc; b.st[1] = nx; }
        const unsigned old = xb_add(&bar[XB_XSUB(b.x)], 1u);
        const unsigned gen = old / nloc;
        if (old + 1u == (gen + 1u) * nloc) {
            __builtin_amdgcn_fence(__ATOMIC_RELEASE, "agent");
            asm volatile("s_waitcnt vmcnt(0)" ::: "memory");
            const unsigned og = xb_add(&bar[XB_TOP], 1u);
            const unsigned tg = og / nx;
            if (og + 1u == (tg + 1u) * nx) xb_add(&bar[XB_TOPGEN], 1u);
            else XB_SPIN(xb_ld(&bar[XB_TOPGEN]) == tg, bar);
            __builtin_amdgcn_fence(__ATOMIC_ACQUIRE, "agent");
            xb_add(&bar[XB_XGEN(b.x)], 1u);
            asm volatile("s_waitcnt vmcnt(0)" ::: "memory");
        } else {
            XB_SPIN(xb_ld(&bar[XB_XGEN(b.x)]) == gen, bar);
            __builtin_amdgcn_fence(__ATOMIC_ACQUIRE, "agent");
            asm volatile("s_waitcnt vmcnt(0)" ::: "memory");
        }
    }
    __syncthreads();
}

namespace pg8 {
constexpr int BM = 256, BK = 64, HALF = 128, HTB = HALF * BK * 2, STAGE_BYTES = 8 * HTB;
__host__ __device__ __forceinline__ int lds_byte(int r, int c) { const int st = (r >> 4) * 2 + (c >> 5), rr = r & 15, cc = c & 31, ob = rr * 64 + cc * 2; return st * 1024 + (ob ^ (((ob >> 9) & 1) << 5)); }
__host__ __device__ __forceinline__ void stage_rc(int b, int& R, int& C) { const int st = b / 1024, sb = b % 1024, swz = sb ^ (((sb >> 9) & 1) << 5); R = (st >> 1) * 16 + swz / 64; C = (st & 1) * 32 + (swz % 64) / 2; }
__host__ __device__ __forceinline__ int invperm32(int j) { return 16 * ((j >> 2) & 1) + 4 * ((j >> 3) & 3) + (j & 3); }

struct GUnit { const char* A; const char* B; int r0, c0, job, aux; };
struct GemmCfg { int lda, ldb, K, kj_tile, kj_bytes; };
typedef f32x4 Acc[2][2][4][2];

__device__ __forceinline__ void tile_of(int wgid, int nM, int nN, int& pm, int& pn) {
    const int nwg = nM * nN;
    { const int q = nwg / 8, r = nwg % 8, xcd = wgid % 8, off = wgid / 8; wgid = (xcd < r ? xcd * (q + 1) : r * (q + 1) + (xcd - r) * q) + off; }
    const int nig = 8 * nN, gid = wgid / nig, fm = gid * 8, gsz = (nM - fm) < 8 ? (nM - fm) : 8;
    pm = fm + ((wgid % nig) % gsz); pn = (wgid % nig) / gsz;
}

template <class Epi, class Sched>
__device__ __forceinline__ void gemm_phase(LAS unsigned char* lds, const GemmCfg g, const Sched& S, const Epi& E) {
    int tid = threadIdx.x; asm volatile("" : "+v"(tid));
    const int wid = __builtin_amdgcn_readfirstlane(tid >> 6), lane = tid & 63, wr = wid >> 2, wc = wid & 3, fr = lane & 15, fq = lane >> 4;
    const int nt = g.K / BK;
    unsigned voffB[2];
#pragma unroll
    for (int i = 0; i < 2; ++i) { int R_, C_; stage_rc(tid * 16 + i * 8192, R_, C_); voffB[i] = (unsigned)(R_ * g.ldb + C_) * 2u; }
    const size_t hstepB = (size_t)HALF * g.ldb * 2, hstepA = Sched::GATHER ? (size_t)0 : (size_t)HALF * g.lda * 2;
    const unsigned ldsw = (unsigned)wid * 1024u;
    const int aoff = lds_byte(wr * 64 + fr, fq * 8), boff = lds_byte(wc * 32 + fr, fq * 8);
#define PG8_SA(b, h) (((b) * 2 + (h)) * HTB)
#define PG8_SB(b, h) ((4 + (b) * 2 + (h)) * HTB)
#define PG8_STAGE2(bufoff, gbase, v0, v1) do { \
        __builtin_amdgcn_global_load_lds((const unsigned*)((const char*)(gbase) + (v0)), (LAS unsigned*)(lds + (bufoff) + ldsw), 16, 0, 0); \
        __builtin_amdgcn_global_load_lds((const unsigned*)((const char*)(gbase) + (v1)), (LAS unsigned*)(lds + (bufoff) + ldsw + 8192), 16, 0, 0); } while (0)
#define PG8_LDA(dst, b, h) do { _Pragma("unroll") for (int m = 0; m < 4; ++m) _Pragma("unroll") for (int k = 0; k < 2; ++k) dst[m][k] = *(const LAS bf16x8*)(lds + PG8_SA(b, h) + aoff + m * 2048 + k * 1024); } while (0)
#define PG8_LDB(dst, b, h) do { _Pragma("unroll") for (int n = 0; n < 2; ++n) _Pragma("unroll") for (int k = 0; k < 2; ++k) dst[n][k] = *(const LAS bf16x8*)(lds + PG8_SB(b, h) + boff + n * 2048 + k * 1024); } while (0)
#define PG8_MMA(ai, bj, At, Bt) do { __builtin_amdgcn_s_setprio(1); _Pragma("unroll") for (int m = 0; m < 4; ++m) _Pragma("unroll") for (int n = 0; n < 2; ++n) _Pragma("unroll") for (int k = 0; k < 2; ++k) \
        acc[ai][bj][m][n] = __builtin_amdgcn_mfma_f32_16x16x32_bf16(Bt[n][k], At[m][k], acc[ai][bj][m][n], 0, 0, 0); __builtin_amdgcn_s_setprio(0); } while (0)
#define PG8_WAIT_V(n) asm volatile("s_waitcnt vmcnt(" #n ")" ::: "memory")
#define PG8_WAIT_L(n) asm volatile("s_waitcnt lgkmcnt(" #n ")" ::: "memory")
#define PG8_BAR __builtin_amdgcn_s_barrier()
#define PG8_SCHED __builtin_amdgcn_sched_barrier(0)
#define PG8_KOFF(kt) ((size_t)(kt) * 128 - (((kt) >= g.kj_tile) ? (size_t)g.kj_bytes : (size_t)0))
    GUnit cur, nxt; int ui = 0;
    if (!S.next(0, cur)) return;
    Acc acc;
#pragma unroll
    for (int a = 0; a < 2; ++a)
#pragma unroll
        for (int b = 0; b < 2; ++b)
#pragma unroll
            for (int m = 0; m < 4; ++m)
#pragma unroll
                for (int n = 0; n < 2; ++n) acc[a][b][m][n] = (f32x4){0.f, 0.f, 0.f, 0.f};
    bf16x8 At[4][2], B0[2][2], B1[2][2];
    unsigned vA00, vA01, vA10, vA11;
    unsigned vN00 = 0, vN01 = 0, vN10 = 0, vN11 = 0;
    S.aoff(cur, g, tid, vA00, vA01, vA10, vA11);
    const char* cA = cur.A; const char* cB = cur.B;
    PG8_STAGE2(PG8_SB(0, 0), cB, voffB[0], voffB[1]); PG8_STAGE2(PG8_SB(0, 1), cB + hstepB, voffB[0], voffB[1]);
    PG8_STAGE2(PG8_SA(0, 0), cA, vA00, vA01); PG8_STAGE2(PG8_SA(0, 1), cA + hstepA, vA10, vA11);
    if (wr == 1) PG8_BAR;
    PG8_WAIT_V(2); PG8_BAR;
    PG8_STAGE2(PG8_SB(1, 0), cB + 128, voffB[0], voffB[1]); PG8_STAGE2(PG8_SA(1, 0), cA + PG8_KOFF(1), vA00, vA01); PG8_STAGE2(PG8_SB(1, 1), cB + hstepB + 128, voffB[0], voffB[1]);
    PG8_WAIT_V(6); PG8_BAR;
    for (;;) {
        const bool has_next = S.next(ui + 1, nxt);
        if constexpr (Sched::GATHER) { if (has_next) S.aoff(nxt, g, tid, vN00, vN01, vN10, vN11); else { vN00 = vA00; vN01 = vA01; vN10 = vA10; vN11 = vA11; }
            asm volatile("" : "+v"(vN00), "+v"(vN01), "+v"(vN10), "+v"(vN11) :: "memory"); }
        const char* nA = has_next ? nxt.A : cA; const char* nB = has_next ? nxt.B : cB;
        int half_empty = 0;
        if constexpr (Sched::GATHER) half_empty = __builtin_amdgcn_readfirstlane((cur.aux - cur.r0) <= 128 ? 1 : 0);
        for (int t = 0; t < nt; t += 2) {
            if constexpr (Sched::GATHER) asm volatile("" : "+s"(half_empty));
            const bool last = (t == nt - 2);
            const char* a1 = cA + PG8_KOFF(t + 1);
            const char* a2 = last ? nA : cA + PG8_KOFF(t + 2); const char* b2 = last ? nB : cB + (size_t)(t + 2) * 128;
            const char* a3 = last ? nA + PG8_KOFF(1) : cA + PG8_KOFF(t + 3); const char* b3 = b2 + 128;
            unsigned w00 = vA00, w01 = vA01, w10 = vA10, w11 = vA11;
            if constexpr (Sched::GATHER) { w00 = last ? vN00 : vA00; w01 = last ? vN01 : vA01; w10 = last ? vN10 : vA10; w11 = last ? vN11 : vA11; }
            PG8_LDB(B0, 0, 0); PG8_LDB(B1, 0, 1); PG8_SCHED; PG8_LDA(At, 0, 0); PG8_STAGE2(PG8_SA(1, 1), a1 + hstepA, vA10, vA11);
            PG8_WAIT_V(8); PG8_WAIT_L(0); PG8_BAR; PG8_MMA(0, 0, At, B0); PG8_MMA(0, 1, At, B1); PG8_BAR; PG8_SCHED;
            PG8_LDA(At, 0, 1); PG8_STAGE2(PG8_SB(0, 0), b2, voffB[0], voffB[1]); PG8_STAGE2(PG8_SB(0, 1), b2 + hstepB, voffB[0], voffB[1]); PG8_STAGE2(PG8_SA(0, 0), a2, w00, w01);
            PG8_WAIT_V(8); PG8_WAIT_L(0); PG8_BAR; if (!half_empty) { PG8_MMA(1, 0, At, B0); PG8_MMA(1, 1, At, B1); } PG8_BAR; PG8_SCHED;
            PG8_LDB(B0, 1, 0); PG8_LDB(B1, 1, 1); PG8_SCHED; PG8_LDA(At, 1, 0); PG8_STAGE2(PG8_SA(0, 1), a2 + hstepA, w10, w11);
            PG8_WAIT_V(8); PG8_WAIT_L(0); PG8_BAR; PG8_MMA(0, 0, At, B0); PG8_MMA(0, 1, At, B1); PG8_BAR; PG8_SCHED;
            PG8_LDA(At, 1, 1); PG8_STAGE2(PG8_SB(1, 0), b3, voffB[0], voffB[1]); PG8_STAGE2(PG8_SB(1, 1), b3 + hstepB, voffB[0], voffB[1]); PG8_STAGE2(PG8_SA(1, 0), a3, w00, w01);
            PG8_WAIT_V(8); PG8_WAIT_L(0); PG8_BAR; if (!half_empty) { PG8_MMA(1, 0, At, B0); PG8_MMA(1, 1, At, B1); } PG8_BAR; PG8_SCHED;
        }
        if (wr == 0) PG8_BAR;
        E(acc, cur, wr, wc, fr, fq);
        if (!has_next) break;
#pragma unroll
        for (int a = 0; a < 2; ++a)
#pragma unroll
            for (int b = 0; b < 2; ++b)
#pragma unroll
                for (int m = 0; m < 4; ++m)
#pragma unroll
                    for (int n = 0; n < 2; ++n) acc[a][b][m][n] = (f32x4){0.f, 0.f, 0.f, 0.f};
        cur = nxt; cA = nA; cB = nB; ++ui;
        if constexpr (Sched::GATHER) { vA00 = vN00; vA01 = vN01; vA10 = vN10; vA11 = vN11; }
        if (wr == 1) PG8_BAR;
    }
    PG8_WAIT_V(0);
    PG8_BAR;
#undef PG8_SA
#undef PG8_SB
#undef PG8_STAGE2
#undef PG8_LDA
#undef PG8_LDB
#undef PG8_MMA
#undef PG8_WAIT_V
#undef PG8_WAIT_L
#undef PG8_BAR
#undef PG8_SCHED
#undef PG8_KOFF
}
__device__ __forceinline__ void dense_aoff(const GemmCfg& g, int tid, unsigned& v00, unsigned& v01, unsigned& v10, unsigned& v11) {
    int R0, C0, R1, C1; stage_rc(tid * 16, R0, C0); stage_rc(tid * 16 + 8192, R1, C1);
    v00 = (unsigned)(R0 * g.lda + C0) * 2u; v01 = (unsigned)(R1 * g.lda + C1) * 2u; v10 = v00; v11 = v01;
}
}
using pg8::GUnit; using pg8::GemmCfg; using pg8::Acc;

#define FOR_AI_M _Pragma("unroll") for (int ai = 0; ai < 2; ++ai) _Pragma("unroll") for (int m = 0; m < 4; ++m)
#define FOR_BJ _Pragma("unroll") for (int bj = 0; bj < 2; ++bj)

__device__ __forceinline__ v4u pack8(const f32x4& a, const f32x4& b) { v4u w; w.x = cvt_pk_bf16(a[0], a[1]); w.y = cvt_pk_bf16(a[2], a[3]); w.z = cvt_pk_bf16(b[0], b[1]); w.w = cvt_pk_bf16(b[2], b[3]); return w; }
__device__ __forceinline__ v2u pack4(const f32x4& a) { v2u w; w.x = cvt_pk_bf16(a[0], a[1]); w.y = cvt_pk_bf16(a[2], a[3]); return w; }

struct EpiStore {
    bf16* O; int ldo; size_t strideO; bool nat;
    __device__ __forceinline__ void operator()(Acc& acc, const GUnit& u, int wr, int wc, int fr, int fq) const {
        bf16* o = O + (size_t)u.job * strideO;
        const int row0 = u.r0 + wr * 64 + fr;
        if (!nat) {
            const int col0 = u.c0 + wc * 32 + 8 * fq;
            FOR_AI_M { bf16* rowp = o + (size_t)(row0 + ai * 128 + m * 16) * ldo + col0;
                FOR_BJ *(v4u*)(rowp + bj * 128) = pack8(acc[ai][bj][m][0], acc[ai][bj][m][1]); }
        } else {
            const int col0 = u.c0 + wc * 32 + 4 * fq;
            FOR_AI_M { bf16* rowp = o + (size_t)(row0 + ai * 128 + m * 16) * ldo + col0;
                FOR_BJ { *(v2u*)(rowp + bj * 128) = pack4(acc[ai][bj][m][0]); *(v2u*)(rowp + bj * 128 + 16) = pack4(acc[ai][bj][m][1]); } }
        }
    }
};
struct EpiLoraDown {
    bf16* O;
    __device__ __forceinline__ void operator()(Acc& acc, const GUnit& u, int wr, int wc, int fr, int fq) const {
        const int row0 = u.r0 + wr * 64 + fr, col0 = wc * 32 + 8 * fq;
        FOR_AI_M { bf16* rowp = O + (size_t)(row0 + ai * 128 + m * 16) * 256 + col0;
            FOR_BJ { f32x4 v0 = acc[ai][bj][m][0], v1 = acc[ai][bj][m][1];
                if (bj == 1) {
#pragma unroll
                    for (int i = 0; i < 4; ++i) { v0[i] = sigmoidf_(v0[i]); v1[i] = sigmoidf_(v1[i]); }
                } else if (wc < 2) {
#pragma unroll
                    for (int i = 0; i < 4; ++i) { v0[i] = 1.0f - 2.0f / (1.0f + __expf(2.0f * v0[i])); v1[i] = 1.0f - 2.0f / (1.0f + __expf(2.0f * v1[i])); }
                }
                *(v4u*)(rowp + bj * 128) = pack8(v0, v1); } }
    }
};
struct EpiLoraUp {
    bf16* LD; bf16* AA; bf16* GG; const float* w0; const float* a0;
    __device__ __forceinline__ void operator()(Acc& acc, const GUnit& u, int wr, int wc, int fr, int fq) const {
        const int kind = u.c0 >> 10, cbase = (u.c0 & 1023) + wc * 32 + 8 * fq;
        bf16* o = LD + (size_t)kind * (UNIT / 2);
        const float* bias = w0; if (kind == 1) bias = a0;
        const int row0 = u.r0 + wr * 64 + fr;
        f32x4 bv[2][2];
        FOR_BJ { bv[bj][0] = kind < 2 ? *(const f32x4*)(bias + cbase + bj * 128) : (f32x4){0.f, 0.f, 0.f, 0.f}; bv[bj][1] = kind < 2 ? *(const f32x4*)(bias + cbase + bj * 128 + 4) : (f32x4){0.f, 0.f, 0.f, 0.f}; }
        FOR_AI_M { bf16* rowp = o + (size_t)(row0 + ai * 128 + m * 16) * DM + cbase;
            FOR_BJ { f32x4 v0 = acc[ai][bj][m][0] + bv[bj][0], v1 = acc[ai][bj][m][1] + bv[bj][1];
                if (kind == 0) {
#pragma unroll
                    for (int i = 0; i < 4; ++i) { v0[i] = -0.6065306597126334f * sigmoidf_(v0[i]); v1[i] = -0.6065306597126334f * sigmoidf_(v1[i]); }
                } else if (kind == 1) {
#pragma unroll
                    for (int i = 0; i < 4; ++i) { v0[i] = sigmoidf_(v0[i]); v1[i] = sigmoidf_(v1[i]); }
                }
                *(v4u*)(rowp + bj * 128) = pack8(v0, v1); } }
    }
};
template <bool NORM, bool SRC32> struct EpiResidual {
    const void* src; bf16* X; int jobrows; float* SSQ; LAS float* xch;
    __device__ __forceinline__ void ld8(size_t off, f32x4& a, f32x4& b) const {
        if (SRC32) { a = *(const f32x4*)((const float*)src + off); b = *(const f32x4*)((const float*)src + off + 4); }
        else { const v4u w = *(const v4u*)((const bf16*)src + off); a = (f32x4){bflo(w.x), bfhi(w.x), bflo(w.y), bfhi(w.y)}; b = (f32x4){bflo(w.z), bfhi(w.z), bflo(w.w), bfhi(w.w)}; }
    }
    __device__ __forceinline__ void operator()(Acc& acc, const GUnit& u, int wr, int wc, int fr, int fq) const {
        const int row0 = u.job * jobrows + u.r0 + wr * 64 + fr, col0 = u.c0 + wc * 32 + 8 * fq;
        f32x4 cur[4], nxt[4];
#define ER_LOAD(dst, g) do { const size_t off_ = (size_t)(row0 + ((g) >> 2) * 128 + ((g) & 3) * 16) * DM + col0; \
            ld8(off_, dst[0], dst[1]); ld8(off_ + 128, dst[2], dst[3]); } while (0)
        ER_LOAD(cur, 0);
#pragma unroll
        for (int g = 0; g < 8; ++g) {
            const int ai = g >> 2, m = g & 3;
            if (g + 1 < 8) ER_LOAD(nxt, g + 1);
            const size_t off = (size_t)(row0 + ai * 128 + m * 16) * DM + col0; float q = 0.f;
#pragma unroll
            for (int bj = 0; bj < 2; ++bj) { const f32x4 x0 = cur[bj * 2] + acc[ai][bj][m][0], x1 = cur[bj * 2 + 1] + acc[ai][bj][m][1];
                *(v4u*)(X + off + bj * 128) = pack8(x0, x1);
                if (NORM) q += ((x0[0] * x0[0] + x0[1] * x0[1]) + (x0[2] * x0[2] + x0[3] * x0[3])) + ((x1[0] * x1[0] + x1[1] * x1[1]) + (x1[2] * x1[2] + x1[3] * x1[3])); }
            if (NORM) { q += __shfl_xor(q, 16); q += __shfl_xor(q, 32); if (fq == 0) xch[(ai * 128 + wr * 64 + m * 16 + fr) * 4 + wc] = q; }
            asm volatile("" ::: "memory");
#pragma unroll
            for (int i = 0; i < 4; ++i) cur[i] = nxt[i];
        }
#undef ER_LOAD
        if (NORM) {
            LDS_WAIT(); __builtin_amdgcn_s_barrier(); asm volatile("" ::: "memory");
            const int t = threadIdx.x;
            if (t < 256) { const f32x4 p = *(const LAS f32x4*)(xch + t * 4); SSQ[(size_t)(u.job * jobrows + u.r0 + t) * 4 + (u.c0 >> 8)] = (p[0] + p[1]) + (p[2] + p[3]); }
            LDS_WAIT(); __builtin_amdgcn_s_barrier(); asm volatile("" ::: "memory");
        }
    }
};
constexpr float ATT_C2 = 0.125f * 1.4426950408889634f;
struct EpiQKVRope {
    bf16* Q; bf16* K; bf16* V; const f32x2* rope; const float* rinv;
    __device__ __forceinline__ void operator()(Acc& acc, const GUnit& u, int wr, int wc, int fr, int fq) const {
        const int kind = u.c0 >> 10, ct = u.c0 & 1023;
        const int row0 = u.r0 + wr * 64 + fr;
        if (kind == 2) {
            const int col0 = ct + wc * 32 + 8 * fq;
            FOR_AI_M { bf16* rowp = V + (size_t)(row0 + ai * 128 + m * 16) * DM + col0; const float ri = rinv[row0 + ai * 128 + m * 16];
                FOR_BJ *(v4u*)(rowp + bj * 128) = pack8(acc[ai][bj][m][0] * ri, acc[ai][bj][m][1] * ri); }
        } else {
            bf16* o = kind == 0 ? Q : K; const float sc0 = kind == 0 ? ATT_C2 : 1.0f;
            const int col0 = ct + wc * 64 + 8 * fq;
            FOR_AI_M { const int row = row0 + ai * 128 + m * 16; const float sc = sc0 * rinv[row];
                const f32x4* rp = (const f32x4*)(rope + (size_t)row * 32 + 8 * fq);
                const f32x4 t0 = rp[0], t1 = rp[1], t2 = rp[2], t3 = rp[3];
                const float cs[8] = {t0[0], t0[2], t1[0], t1[2], t2[0], t2[2], t3[0], t3[2]};
                const float sn[8] = {t0[1], t0[3], t1[1], t1[3], t2[1], t2[3], t3[1], t3[3]};
                f32x4 lo0, lo1, hi0, hi1;
#pragma unroll
                for (int i = 0; i < 4; ++i) {
                    const float x1a = acc[ai][0][m][0][i], x2a = acc[ai][1][m][0][i], x1b = acc[ai][0][m][1][i], x2b = acc[ai][1][m][1][i];
                    lo0[i] = (x1a * cs[i] - x2a * sn[i]) * sc; hi0[i] = (x2a * cs[i] + x1a * sn[i]) * sc;
                    lo1[i] = (x1b * cs[4 + i] - x2b * sn[4 + i]) * sc; hi1[i] = (x2b * cs[4 + i] + x1b * sn[4 + i]) * sc; }
                bf16* rowp = o + (size_t)row * DM + col0;
                *(v4u*)(rowp) = pack8(lo0, lo1); *(v4u*)(rowp + 32) = pack8(hi0, hi1); }
        }
    }
};
struct EpiSoftmax {
    bf16* P; LAS float* xch; const float* SSQ;
    __device__ __forceinline__ void operator()(Acc& acc, const GUnit& u, int wr, int wc, int fr, int fq) const {
        constexpr float SC = 0.0625f * 1.4426950408889634f;
        LAS float* Mx = xch; LAS float* Sx = xch + 1024;
        FOR_AI_M { const f32x4 q = *(const f32x4*)(SSQ + (size_t)(u.r0 + ai * 128 + wr * 64 + m * 16 + fr) * 4);
            const float ri = 1.0f / sqrtf(((q[0] + q[1]) + (q[2] + q[3])) * (1.0f / DM) + RMS_EPS);
            FOR_BJ { acc[ai][bj][m][0] = acc[ai][bj][m][0] * ri; acc[ai][bj][m][1] = acc[ai][bj][m][1] * ri; } }
        FOR_AI_M { float v = -INFINITY;
            FOR_BJ {
#pragma unroll
                for (int n = 0; n < 2; ++n) { const f32x4 x = acc[ai][bj][m][n]; v = fmaxf(v, fmaxf(fmaxf(x[0], x[1]), fmaxf(x[2], x[3]))); } }
            v = fmaxf(v, __shfl_xor(v, 16)); v = fmaxf(v, __shfl_xor(v, 32));
            if (fq == 0) Mx[(ai * 128 + wr * 64 + m * 16 + fr) * 4 + wc] = v; }
        LDS_WAIT(); __builtin_amdgcn_s_barrier(); asm volatile("" ::: "memory");
        FOR_AI_M { const f32x4 q = *(const LAS f32x4*)(Mx + (ai * 128 + wr * 64 + m * 16 + fr) * 4);
            const float mm = fmaxf(fmaxf(q[0], q[1]), fmaxf(q[2], q[3])) * SC; float s = 0.f;
            FOR_BJ {
#pragma unroll
                for (int n = 0; n < 2; ++n) { f32x4 x = acc[ai][bj][m][n];
#pragma unroll
                    for (int i = 0; i < 4; ++i) { x[i] = __builtin_amdgcn_exp2f(x[i] * SC - mm); s += x[i]; }
                    acc[ai][bj][m][n] = x; } }
            s += __shfl_xor(s, 16); s += __shfl_xor(s, 32);
            if (fq == 0) Sx[(ai * 128 + wr * 64 + m * 16 + fr) * 4 + wc] = s; }
        LDS_WAIT(); __builtin_amdgcn_s_barrier(); asm volatile("" ::: "memory");
        const int row0 = u.r0 + wr * 64 + fr, col0 = u.c0 + wc * 32 + 4 * fq;
        FOR_AI_M { const f32x4 q = *(const LAS f32x4*)(Sx + (ai * 128 + wr * 64 + m * 16 + fr) * 4);
            const float inv = 1.0f / ((q[0] + q[1]) + (q[2] + q[3]));
            bf16* rowp = P + (size_t)(row0 + ai * 128 + m * 16) * DM + col0;
            FOR_BJ { *(v2u*)(rowp + bj * 128) = pack4(acc[ai][bj][m][0] * inv); *(v2u*)(rowp + bj * 128 + 16) = pack4(acc[ai][bj][m][1] * inv); } }
        LDS_WAIT(); __builtin_amdgcn_s_barrier(); asm volatile("" ::: "memory");
    }
};
struct EpiMoE1 {
    bf16* H; const int* pairlist; const float* rinv;
    __device__ __forceinline__ void operator()(Acc& acc, const GUnit& u, int wr, int wc, int fr, int fq) const {
        const int e = u.job, n_e = u.aux;
        const int col0 = u.c0 + wc * 32 + 8 * fq;
        int pr_[2][4]; float ri_[2][4];
        FOR_AI_M { const int rank = u.r0 + ai * 128 + wr * 64 + m * 16 + fr; pr_[ai][m] = rank < n_e ? pairlist[(size_t)e * PLCAP + rank] : 0; }
        FOR_AI_M ri_[ai][m] = rinv[pr_[ai][m] >> 1];
        FOR_AI_M { const int rank = u.r0 + ai * 128 + wr * 64 + m * 16 + fr;
            if (rank < n_e) { const int pair = pr_[ai][m]; const float ri = ri_[ai][m];
                f32x4 h0, h1;
#pragma unroll
                for (int i = 0; i < 4; ++i) { const float a0 = acc[ai][0][m][0][i] * ri, a1 = acc[ai][0][m][1][i] * ri;
                    h0[i] = a0 * sigmoidf_(a0) * (acc[ai][1][m][0][i] * ri); h1[i] = a1 * sigmoidf_(a1) * (acc[ai][1][m][1][i] * ri); }
                *(v4u*)(H + (size_t)pair * FF + col0) = pack8(h0, h1); } }
    }
};
constexpr float Y_SCALE = 16.0f;
__device__ __forceinline__ unsigned pk4_fp8(const f32x4& v) { int w = 0; w = __builtin_amdgcn_cvt_pk_fp8_f32(v[0], v[1], w, false); w = __builtin_amdgcn_cvt_pk_fp8_f32(v[2], v[3], w, true); return (unsigned)w; }
struct EpiMoE2 {
    unsigned char* Y; const int* pairlist; const float* gate;
    __device__ __forceinline__ void operator()(Acc& acc, const GUnit& u, int wr, int wc, int fr, int fq) const {
        const int e = u.job, n_e = u.aux;
        const int col0 = u.c0 + wc * 32 + 8 * fq;
        int pr_[2][4]; float gt_[2][4];
        FOR_AI_M { const int rank = u.r0 + ai * 128 + wr * 64 + m * 16 + fr; pr_[ai][m] = rank < n_e ? pairlist[(size_t)e * PLCAP + rank] : 0; }
        FOR_AI_M gt_[ai][m] = gate[pr_[ai][m]];
        FOR_AI_M { const int rank = u.r0 + ai * 128 + wr * 64 + m * 16 + fr;
            if (rank < n_e) { const int pair = pr_[ai][m]; const float gt = gt_[ai][m] * Y_SCALE;
                unsigned char* rowp = Y + (size_t)pair * DM + col0;
                FOR_BJ { v2u w; w.x = pk4_fp8(acc[ai][bj][m][0] * gt); w.y = pk4_fp8(acc[ai][bj][m][1] * gt); *(v2u*)(rowp + bj * 128) = w; } } }
    }
};

struct BatchSched {
    static constexpr bool GATHER = false;
    int G, c, nb, nM, nN, lda, ldb; const char* A; const char* B; size_t strideA, strideB; bool plain;
    __device__ __forceinline__ bool next(int i, GUnit& u) const {
        const int L = i * G + c, per = nM * nN; if (L >= nb * per) return false;
        const int s = L / per; int pm, pn; if (plain) { pm = (L - s * per) / nN; pn = (L - s * per) % nN; } else pg8::tile_of(L - s * per, nM, nN, pm, pn);
        u.A = A + (size_t)s * strideA + (size_t)pm * 256 * lda * 2; u.B = B + (size_t)s * strideB + (size_t)pn * 256 * ldb * 2; u.r0 = pm * 256; u.c0 = pn * 256; u.job = s; u.aux = 0; return true;
    }
    __device__ __forceinline__ void aoff(const GUnit&, const GemmCfg& g, int tid, unsigned& v00, unsigned& v01, unsigned& v10, unsigned& v11) const { pg8::dense_aoff(g, tid, v00, v01, v10, v11); }
};
struct LoraDownSched {
    static constexpr bool GATHER = false;
    int G, c; const char* hp; const char* B;
    __device__ __forceinline__ bool next(int i, GUnit& u) const {
        const int L = i * G + c; if (L >= NTOK / 256) return false;
        const int b = L / (SEQ / 256), t0 = (L % (SEQ / 256)) * 256;
        u.A = hp + ((size_t)b * (SEQ + 1) + 1 + t0) * DM * 2; u.B = B; u.r0 = L * 256; u.c0 = 0; u.job = 0; u.aux = 0; return true;
    }
    __device__ __forceinline__ void aoff(const GUnit&, const GemmCfg& g, int tid, unsigned& v00, unsigned& v01, unsigned& v10, unsigned& v11) const { pg8::dense_aoff(g, tid, v00, v01, v10, v11); }
};
struct XAttnSched {
    static constexpr bool GATHER = false;
    int G, c, mode; const char* A; const char* B;
    __device__ __forceinline__ bool next(int i, GUnit& u) const {
        const int L = i * G + c; u.aux = 0;
        if (mode == 2) { if (L >= BATCH * MEMH * (SEQ / 256)) return false;
            const int tt = L % (SEQ / 256), bh = L / (SEQ / 256), h = bh % MEMH, b = bh / MEMH;
            u.A = A + ((size_t)b * SEQ + tt * 256) * DM * 2; u.B = B + (size_t)bh * MEMT * DM * 2; u.r0 = b * SEQ + tt * 256; u.c0 = h * 256; u.job = 0; return true; }
        if (L >= BATCH * MEMH * 4) return false;
        const int q = L & 3, bh = L >> 2, h = bh % MEMH, b = bh / MEMH;
        if (mode == 0) { u.A = A + ((size_t)b * MEMT * DM + h * 256) * 2; u.B = B + ((size_t)q * 256 * DM + h * 256) * 2; u.r0 = 0; u.c0 = q * 256; u.job = bh; }
        else { u.A = A + ((size_t)q * 256 * DM + h * 256) * 2; u.B = B + ((size_t)b * MEMT * DM + h * 256) * 2; u.r0 = q * 256; u.c0 = h * 256; u.job = b; }
        return true;
    }
    __device__ __forceinline__ void aoff(const GUnit&, const GemmCfg& g, int tid, unsigned& v00, unsigned& v01, unsigned& v10, unsigned& v11) const { pg8::dense_aoff(g, tid, v00, v01, v10, v11); }
};
struct MoeSched {
    static constexpr bool GATHER = true;
    int G, c, shift, ncol, cstep; const char* A; const char* B; size_t bstride_e, bstride_n; const int* pairlist; const LAS int* tab;
    __device__ __forceinline__ bool next(int i, GUnit& u) const {
        const int L = i * G + c, pn = L % ncol, rt = L / ncol, lane = threadIdx.x & 63, q = lane & 31;
        const int nf = tab[96], np = tab[97];
        if (rt >= nf + np) return false;
        int e, r0;
        if (rt < nf) { const int f = tab[q] >> 8, st = tab[32 + q];
            const unsigned long long hit = __ballot(lane < 32 && rt >= st && rt < st + f);
            e = __builtin_ctzll(hit); r0 = (rt - __builtin_amdgcn_readlane(st, e)) * 256; }
        else { e = tab[64 + (rt - nf)]; r0 = (tab[e] >> 8) * 256; }
        e = __builtin_amdgcn_readfirstlane(e); r0 = __builtin_amdgcn_readfirstlane(r0);
        const int n_e = __builtin_amdgcn_readfirstlane(tab[e]);
        u.A = A; u.B = B + (size_t)e * bstride_e + (size_t)pn * bstride_n; u.r0 = r0; u.c0 = pn * cstep; u.job = e; u.aux = n_e; return true;
    }
    __device__ __forceinline__ void aoff(const GUnit& u, const GemmCfg& g, int tid, unsigned& v00, unsigned& v01, unsigned& v10, unsigned& v11) const {
        const int* pl = pairlist + (size_t)u.job * PLCAP + u.r0; const int lim = u.aux - u.r0;
        int sR[2], sC[2]; pg8::stage_rc(tid * 16, sR[0], sC[0]); pg8::stage_rc(tid * 16 + 8192, sR[1], sC[1]);
        const int r00 = sR[0], r01 = sR[1], r10 = pg8::HALF + sR[0], r11 = pg8::HALF + sR[1];
        const int p00 = r00 < lim ? pl[r00] >> shift : 0, p01 = r01 < lim ? pl[r01] >> shift : 0, p10 = r10 < lim ? pl[r10] >> shift : 0, p11 = r11 < lim ? pl[r11] >> shift : 0;
        v00 = (unsigned)(p00 * g.lda + sC[0]) * 2u; v01 = (unsigned)(p01 * g.lda + sC[1]) * 2u; v10 = (unsigned)(p10 * g.lda + sC[0]) * 2u; v11 = (unsigned)(p11 * g.lda + sC[1]) * 2u;
    }
};

namespace attn_body {
using bf16=__hip_bfloat16;
using bf16x8=__attribute__((ext_vector_type(8)))short;
using s16x4=__attribute__((ext_vector_type(4)))short;
using f32x16=__attribute__((ext_vector_type(16)))float;
using u32x4=__attribute__((ext_vector_type(4)))unsigned;
constexpr int NHEAD=16,SEQ=2048,D=64,DM=NHEAD*D;
constexpr int NW=8,QBLK=32,QB=QBLK*NW,KVBLK=64,NQB=SEQ/QB;
__device__ __forceinline__ int crow(int r,int hi){return (r&3)+8*(r>>2)+4*hi;}
#define SBAR() __builtin_amdgcn_sched_barrier(0)
__device__ __forceinline__ void cmask(f32x16&p0,f32x16&p1,int jb,int qrel,int hi){
  const float NEG=-INFINITY; int kb=64*jb+4*hi;
  #pragma unroll
  for(int r=0;r<16;++r){int kv=kb+(r&3)+8*(r>>2); if(kv>qrel)p0[r]=NEG; if(kv+32>qrel)p1[r]=NEG;}
}
__device__ __forceinline__ void allmask(f32x16&p0,f32x16&p1){
  const float NEG=-INFINITY;
  #pragma unroll
  for(int r=0;r<16;++r){p0[r]=NEG;p1[r]=NEG;}
}
constexpr int NSLOT=3, SLOTB=8192;
constexpr int LDS_K=0, LDS_V=NSLOT*SLOTB, LDS_WS=2*NSLOT*SLOTB, LDS_OST=LDS_WS+NW*64*4, LDS_BYTES=LDS_OST+NW*4096;
constexpr int LDS_KMEAN=86016;
constexpr float C2=0.125f*1.4426950408889634f;
__device__ __forceinline__ void glds16(const void*gsrc,unsigned lds_dst){unsigned keep;
  asm volatile("s_mov_b32 %0, m0\n\ts_mov_b32 m0, %2\n\ts_nop 0\n\tglobal_load_lds_dwordx4 %1, off\n\ts_mov_b32 m0, %0":"=&s"(keep):"v"(gsrc),"s"(lds_dst):"memory");}
__device__ __forceinline__ float max3f(float a,float b,float c){float r;asm("v_max3_f32 %0, %1, %2, %3":"=v"(r):"v"(a),"v"(b),"v"(c));return r;}
__device__ __forceinline__ float max2f(float a,float b){float r;asm("v_max_f32_e32 %0, %1, %2":"=v"(r):"v"(a),"v"(b));return r;}
__device__ __forceinline__ float fadd_s(float a,float b){float r;asm("v_add_f32_e32 %0, %1, %2":"=v"(r):"v"(a),"v"(b));return r;}
__device__ __forceinline__ float fsub_s(float a,float b){float r;asm("v_sub_f32_e32 %0, %1, %2":"=v"(r):"v"(a),"v"(b));return r;}
typedef float f32x2_t __attribute__((ext_vector_type(2))); typedef __bf16 bf16x2_t __attribute__((ext_vector_type(2)));
__device__ __forceinline__ unsigned cvtpk_s(float lo,float hi){f32x2_t v={lo,hi};bf16x2_t b=__builtin_convertvector(v,bf16x2_t);return __builtin_bit_cast(unsigned,b);}
#define WAIT_BAR(N) asm volatile("s_waitcnt vmcnt(" #N ") lgkmcnt(0)\n\ts_barrier":::"memory")
__device__ __forceinline__ void qkt(f32x16&p0,f32x16&p1,const char*Kslot,const bf16x8*qr,int r32,int hi){ const f32x16 negm=f32x16{};
  const char*kb=Kslot+hi*1024+r32*16;
  #pragma unroll
  for(int d0=0;d0<4;++d0){
    const bf16x8 b0=*reinterpret_cast<const bf16x8*>(kb+d0*2048);
    const bf16x8 b1=*reinterpret_cast<const bf16x8*>(kb+d0*2048+512);
    if(d0==0){p0=__builtin_amdgcn_mfma_f32_32x32x16_bf16(b0,qr[0],negm,0,0,0);p1=__builtin_amdgcn_mfma_f32_32x32x16_bf16(b1,qr[0],negm,0,0,0);}
    else{p0=__builtin_amdgcn_mfma_f32_32x32x16_bf16(b0,qr[d0],p0,0,0,0);p1=__builtin_amdgcn_mfma_f32_32x32x16_bf16(b1,qr[d0],p1,0,0,0);}}
}
typedef __attribute__((address_space(3))) const char* lds_cptr;
typedef short v4i16_t __attribute__((ext_vector_type(4)));
__device__ __forceinline__ void kload8(bf16x8*kf,lds_cptr kp){
  kf[0]=*(const __attribute__((address_space(3))) bf16x8*)(kp);      kf[1]=*(const __attribute__((address_space(3))) bf16x8*)(kp+512);
  kf[2]=*(const __attribute__((address_space(3))) bf16x8*)(kp+2048); kf[3]=*(const __attribute__((address_space(3))) bf16x8*)(kp+2560);
  kf[4]=*(const __attribute__((address_space(3))) bf16x8*)(kp+4096); kf[5]=*(const __attribute__((address_space(3))) bf16x8*)(kp+4608);
  kf[6]=*(const __attribute__((address_space(3))) bf16x8*)(kp+6144); kf[7]=*(const __attribute__((address_space(3))) bf16x8*)(kp+6656);
}
__device__ __forceinline__ void kload2(bf16x8*kf,lds_cptr kp,int j){ kf[2*j]=*(const __attribute__((address_space(3))) bf16x8*)(kp+j*2048); kf[2*j+1]=*(const __attribute__((address_space(3))) bf16x8*)(kp+j*2048+512); }
__device__ __forceinline__ s16x4 vtr(lds_cptr p){ return __builtin_bit_cast(s16x4,__builtin_amdgcn_ds_read_tr16_b64_v4i16((__attribute__((address_space(3))) v4i16_t*)p)); }
__device__ __forceinline__ float rowmax(const f32x16&p0,const f32x16&p1){
  float a=max3f(p0[0],p0[1],p1[0]),b=max3f(p0[2],p0[3],p1[1]);a=max3f(a,p1[2],p1[3]);
  #pragma unroll
  for(int r=4;r<16;r+=4){a=max3f(a,p0[r],p0[r+1]);b=max3f(b,p0[r+2],p0[r+3]);a=max3f(a,p1[r],p1[r+1]);b=max3f(b,p1[r+2],p1[r+3]);}
  const float m=max2f(a,b);
  auto rr=__builtin_amdgcn_permlane32_swap(__float_as_uint(m),__float_as_uint(m),false,false);
  return max2f(__uint_as_float(rr[0]),__uint_as_float(rr[1]));
}
__device__ __forceinline__ void pv(f32x16*o,int vb,bf16x8 pa0,bf16x8 pa1,bf16x8 pa2,bf16x8 pa3){
  #pragma unroll
  for(int d0=0;d0<2;++d0){s16x4 lo[4],hi[4];
    #pragma unroll
    for(int ks=0;ks<4;++ks){
      asm volatile("ds_read_b64_tr_b16 %0,%1 offset:%c2":"=&v"(lo[ks]):"v"(vb),"i"(d0*4096+ks*1024):"memory");
      asm volatile("ds_read_b64_tr_b16 %0,%1 offset:%c2":"=&v"(hi[ks]):"v"(vb),"i"(d0*4096+ks*1024+512):"memory");}
    asm volatile("s_waitcnt lgkmcnt(0)":::"memory");SBAR();
    #define PK(k) (bf16x8){lo[k][0],lo[k][1],lo[k][2],lo[k][3],hi[k][0],hi[k][1],hi[k][2],hi[k][3]}
    o[d0]=__builtin_amdgcn_mfma_f32_32x32x16_bf16(pa0,PK(0),o[d0],0,0,0);
    o[d0]=__builtin_amdgcn_mfma_f32_32x32x16_bf16(pa1,PK(1),o[d0],0,0,0);
    o[d0]=__builtin_amdgcn_mfma_f32_32x32x16_bf16(pa2,PK(2),o[d0],0,0,0);
    o[d0]=__builtin_amdgcn_mfma_f32_32x32x16_bf16(pa3,PK(3),o[d0],0,0,0);
    #undef PK
  }
}
#ifndef ATTN_STORE16
#define ATTN_STORE16(p,v) (*(u32x4*)(p)=(v))
#endif
template<int THRL> __device__ __forceinline__ void attn_unit(int b,int h,int qb,const bf16*Q,const bf16*__restrict__ K,const bf16*__restrict__ V,bf16*O,char*shm){
  const int tid=threadIdx.x,lane=tid&63,r32=lane&31,hi=lane>>5; const int wid=__builtin_amdgcn_readfirstlane(tid>>6);
  const long rowbase=(long)b*SEQ; const int q0=qb*QB;
  const bf16*Qw=Q+(rowbase+q0+wid*QBLK)*DM+h*D;
  const bf16*Kh=K+rowbase*DM+h*D,*Vh=V+rowbase*DM+h*D;
  const unsigned lds0=(unsigned)(uintptr_t)shm;
  float*wsf=(float*)(shm+LDS_WS)+wid*64;
  const bf16*ksrc=Kh+(long)lane*DM+wid*8;
  const bf16*vsrc=Vh+(long)(16*(wid&3)+(lane>>2))*DM+(wid>>2)*32+(lane&3)*8;
  const unsigned kdst=lds0+LDS_K+wid*1024, vdst=lds0+LDS_V+wid*1024;
  const int NT=(q0+QB)/KVBLK;
  #define TMAP(t) (((t)<4)?(NT-4+(t)):((t)-4))
  #define DMA_K(t,slot) glds16(ksrc+(long)TMAP(t)*KVBLK*DM,(unsigned)__builtin_amdgcn_readfirstlane(kdst+(slot)))
  #define DMA_V(t,slot) glds16(vsrc+(long)TMAP(t)*KVBLK*DM,(unsigned)__builtin_amdgcn_readfirstlane(vdst+(slot)))
  const int vb0=(int)(lds0+LDS_V)+((lane>>4)&1)*32+(lane&3)*8+(4*hi+((lane&15)>>2))*64;
  const char*Kbase=shm+LDS_K; bf16x8 kf[8];
  const lds_cptr shm3=(lds_cptr)shm; const lds_cptr kp0=shm3+LDS_K+hi*1024+r32*16; const lds_cptr vp0=shm3+LDS_V+((lane>>4)&1)*32+(lane&3)*8+(4*hi+((lane&15)>>2))*64;
  DMA_K(0,0);DMA_V(0,0);DMA_K(1,SLOTB);
  bf16x8 qr[4];
  #pragma unroll
  for(int d0=0;d0<4;++d0)qr[d0]=*reinterpret_cast<const bf16x8*>(&Qw[(long)r32*DM+d0*16+hi*8]);
  unsigned selbits=0u;
  { const __attribute__((address_space(3))) float*km=(const __attribute__((address_space(3))) float*)((lds_cptr)shm+LDS_KMEAN); float g[7];
    #pragma unroll
    for(int j=0;j<7;++j){ float s=-INFINITY;
      if(j<qb){ s=0.f;
        #pragma unroll
        for(int d0=0;d0<4;++d0){ const __attribute__((address_space(3))) float*kp=km+j*64+d0*16+hi*8;
          #pragma unroll
          for(int e=0;e<8;++e) s+=__uint_as_float(((unsigned)(unsigned short)qr[d0][e])<<16)*kp[e]; }
        auto rr=__builtin_amdgcn_permlane32_swap(__float_as_uint(s),__float_as_uint(s),false,false);
        s=__uint_as_float(rr[0])+__uint_as_float(rr[1]); }
      g[j]=s; }
    #pragma unroll
    for(int pass=0;pass<3;++pass){ float best=-INFINITY; int bi=-1;
      #pragma unroll
      for(int j=0;j<7;++j){ const bool ok=(j<qb)&&!((selbits>>j)&1u)&&(g[j]>best); if(ok){best=g[j];bi=j;} }
      if(bi>=0)selbits|=(1u<<bi); }
  }
  float mhat=0.f,l_reg=0.f;f32x16 o[2];o[0]=f32x16{};o[1]=f32x16{};
  const int qrel=wid*QBLK+r32;
  #define CMASK(P0,P1,t) do{ const int t_=(t); if(t_<4){cmask(P0,P1,t_,qrel,hi);} else { if(!((selbits>>(((t_-4)>>2)&7))&1u)) allmask(P0,P1); } }while(0)
  bool resc=false;
  #define START(P0,P1) do{ const float rm=rowmax(P0,P1); resc=false; \
    { const float dl=rm; mhat=fadd_s(mhat,dl); \
      _Pragma("unroll") for(int r=0;r<16;++r){P0[r]=fsub_s(P0[r],dl);P1[r]=fsub_s(P1[r],dl);} \
      } \
    _Pragma("unroll") for(int r=0;r<16;++r)P0[r]=__builtin_amdgcn_exp2f(P0[r]); }while(0)
  #define RESC() do{ if(resc){ asm volatile("s_waitcnt lgkmcnt(0)":::"memory"); \
      _Pragma("unroll") for(int d_=0;d_<2;++d_) _Pragma("unroll") for(int r=0;r<16;++r)o[d_][r]*=wsf[crow(r,hi)]; } }while(0)
  f32x16 pA0,pA1,pB0,pB1;
  int sl_prev=0,sl_cur=0,sl_next=SLOTB;
  #define ROT() do{sl_prev=sl_cur;sl_cur=sl_next;sl_next=(sl_next==(NSLOT-1)*SLOTB)?0:sl_next+SLOTB;}while(0)
  DMA_K(2,2*SLOTB);
  WAIT_BAR(3);
  qkt(pA0,pA1,Kbase,qr,r32,hi);asm volatile("s_nop 15\n\ts_nop 7":"+v"(pA0),"+v"(pA1));CMASK(pA0,pA1,0);
  START(pA0,pA1);
  _Pragma("unroll") for(int r=0;r<16;++r)pA1[r]=__builtin_amdgcn_exp2f(pA1[r]);
  WAIT_BAR(0);
  DMA_K(3,0);DMA_V(1,SLOTB);
  ROT();
  kload8(kf,kp0+sl_cur);
  WAIT_BAR(2);
  s16x4 vlo[8],vhi[8]; u32x4 pw0,pw1,pw2,pw3;
  #define PKW(P,B) cvtpk_s(P[B],P[B+1])
  #define PAF(k) __builtin_bit_cast(bf16x8,pw##k)
  #define VFR(i) (bf16x8){vlo[i][0],vlo[i][1],vlo[i][2],vlo[i][3],vhi[i][0],vhi[i][1],vhi[i][2],vhi[i][3]}
  #define PIN(x) asm volatile("":"+v"(x))
  #define MX3(a,b,c) __builtin_fmaxf(__builtin_fmaxf((a),(b)),(c))
  #define GAPA(MF,A0,A1,A2,A3,W0,W1,PW) do{ MF; sacc+=A0; sacc+=A1; sacc+=A2; sacc+=A3; PIN(sacc); W0; W1; PIN(PW); SBAR(); }while(0)
  #define EX(v) __builtin_amdgcn_exp2f(v)
  #define GAPB(MF,X,B) do{ MF; X[B]=EX(X[B]); X[B+1]=EX(X[B+1]); X[B+2]=EX(X[B+2]); X[B+3]=EX(X[B+3]); PIN(X); SBAR(); }while(0)
  #define VRD(i) do{ vlo[i]=vtr(vp_+(((i)>>2)*4096+((i)&3)*1024)); vhi[i]=vtr(vp_+(((i)>>2)*4096+((i)&3)*1024+512)); }while(0)
  #define KRD(G,j) do{ if(G){ kload2(kf,kp0+sl_next,j); SBAR(); } }while(0)
  #define STEP(C0,C1,P0,P1,t,GK,GV,GL) do{ SBAR(); \
    const lds_cptr vp_=vp0+sl_prev; \
    VRD(0); SBAR(); float sacc=(P0[0]+P0[1]); \
    GAPA(C0=__builtin_amdgcn_mfma_f32_32x32x16_bf16(kf[0],qr[0],f32x16{},0,0,0), P0[2],P0[3],P0[4],P0[5],     pw0[0]=PKW(P0,0), pw0[1]=PKW(P0,2), pw0); \
    VRD(4); SBAR(); GAPA(C1=__builtin_amdgcn_mfma_f32_32x32x16_bf16(kf[1],qr[0],f32x16{},0,0,0), P0[6],P0[7],P0[8],P0[9],     pw0[2]=PKW(P0,4), pw0[3]=PKW(P0,6), pw0); \
    VRD(1); SBAR(); GAPA(C0=__builtin_amdgcn_mfma_f32_32x32x16_bf16(kf[2],qr[1],C0,0,0,0),   P0[10],P0[11],P0[12],P0[13], pw1[0]=PKW(P0,8), pw1[1]=PKW(P0,10), pw1); \
    VRD(5); SBAR(); GAPA(C1=__builtin_amdgcn_mfma_f32_32x32x16_bf16(kf[3],qr[1],C1,0,0,0),   P0[14],P0[15],P1[0],P1[1],   pw1[2]=PKW(P0,12),pw1[3]=PKW(P0,14), pw1); \
    VRD(2); SBAR(); GAPA(C0=__builtin_amdgcn_mfma_f32_32x32x16_bf16(kf[4],qr[2],C0,0,0,0),   P1[2],P1[3],P1[4],P1[5],     pw2[0]=PKW(P1,0), pw2[1]=PKW(P1,2), pw2); \
    VRD(6); SBAR(); GAPA(C1=__builtin_amdgcn_mfma_f32_32x32x16_bf16(kf[5],qr[2],C1,0,0,0),   P1[6],P1[7],P1[8],P1[9],     pw2[2]=PKW(P1,4), pw2[3]=PKW(P1,6), pw2); \
    VRD(3); SBAR(); GAPA(C0=__builtin_amdgcn_mfma_f32_32x32x16_bf16(kf[6],qr[3],C0,0,0,0),   P1[10],P1[11],P1[12],P1[13], pw3[0]=PKW(P1,8), pw3[1]=PKW(P1,10), pw3); \
    VRD(7); SBAR(); GAPA(C1=__builtin_amdgcn_mfma_f32_32x32x16_bf16(kf[7],qr[3],C1,0,0,0),   P1[14],P1[15],0.f,0.f,       pw3[2]=PKW(P1,12),pw3[3]=PKW(P1,14), pw3); \
    l_reg+=sacc; \
    if(GK){DMA_K((t)+3,sl_cur);} if(GV){DMA_V((t)+1,sl_next);} \
    CMASK(C0,C1,t); \
    _Pragma("unroll") for(int r=0;r<16;++r){C0[r]-=mhat;C1[r]-=mhat;} \
    { float a=MX3(C0[0],C0[1],C1[0]),b=MX3(C0[2],C0[3],C1[1]); a=MX3(a,C1[2],C1[3]); \
      _Pragma("unroll") for(int r=4;r<16;r+=4){a=MX3(a,C0[r],C0[r+1]);b=MX3(b,C0[r+2],C0[r+3]);a=MX3(a,C1[r],C1[r+1]);b=MX3(b,C1[r+2],C1[r+3]);} \
      float rm=__builtin_fmaxf(a,b); { auto rr=__builtin_amdgcn_permlane32_swap(__float_as_uint(rm),__float_as_uint(rm),false,false); rm=__builtin_fmaxf(__uint_as_float(rr[0]),__uint_as_float(rr[1])); } \
      resc=false; \
      if(__builtin_expect(__any(rm>(float)THRL),0)){ const float dl=__builtin_fmaxf(rm,0.f); mhat+=dl; \
        _Pragma("unroll") for(int r=0;r<16;++r){C0[r]-=dl;C1[r]-=dl;} \
        const float f=__builtin_amdgcn_exp2f(-dl); l_reg*=f; if(hi==0)wsf[r32]=f; resc=true; } } \
    SBAR(); \
    GAPB(o[0]=__builtin_amdgcn_mfma_f32_32x32x16_bf16(PAF(0),VFR(0),o[0],0,0,0), C0,0); \
    GAPB(o[1]=__builtin_amdgcn_mfma_f32_32x32x16_bf16(PAF(0),VFR(4),o[1],0,0,0), C0,4); \
    KRD(GL,0); GAPB(o[0]=__builtin_amdgcn_mfma_f32_32x32x16_bf16(PAF(1),VFR(1),o[0],0,0,0), C0,8); \
    KRD(GL,1); GAPB(o[1]=__builtin_amdgcn_mfma_f32_32x32x16_bf16(PAF(1),VFR(5),o[1],0,0,0), C0,12); \
    KRD(GL,2); GAPB(o[0]=__builtin_amdgcn_mfma_f32_32x32x16_bf16(PAF(2),VFR(2),o[0],0,0,0), C1,0); \
    KRD(GL,3); GAPB(o[1]=__builtin_amdgcn_mfma_f32_32x32x16_bf16(PAF(2),VFR(6),o[1],0,0,0), C1,4); \
    GAPB(o[0]=__builtin_amdgcn_mfma_f32_32x32x16_bf16(PAF(3),VFR(3),o[0],0,0,0), C1,8); \
    GAPB(o[1]=__builtin_amdgcn_mfma_f32_32x32x16_bf16(PAF(3),VFR(7),o[1],0,0,0), C1,12); \
    }while(0)
  int t=1;
  for(;t+5<NT;t+=2){
    STEP(pB0,pB1,pA0,pA1,t,true,true,true);     WAIT_BAR(2); RESC(); ROT();
    STEP(pA0,pA1,pB0,pB1,t+1,true,true,true);   WAIT_BAR(2); RESC(); ROT();
  }
  #define ENDW(tt) do{ if((tt)+3<NT){WAIT_BAR(2);} else if((tt)+2<NT){WAIT_BAR(1);} else {WAIT_BAR(0);} }while(0)
  for(;t+1<NT;t+=2){
    STEP(pB0,pB1,pA0,pA1,t,(t+3<NT),(t+1<NT),(t+1<NT));       ENDW(t);   RESC(); ROT();
    STEP(pA0,pA1,pB0,pB1,t+1,(t+4<NT),(t+2<NT),(t+2<NT));     ENDW(t+1); RESC(); ROT();
  }
  STEP(pB0,pB1,pA0,pA1,NT-1,false,false,false); RESC();
  { float sacc=pB0[0]+pB0[1]; _Pragma("unroll") for(int r=2;r<16;++r)sacc+=pB0[r]; _Pragma("unroll") for(int r=0;r<16;++r)sacc+=pB1[r]; l_reg+=sacc;
    pw0=(u32x4){PKW(pB0,0),PKW(pB0,2),PKW(pB0,4),PKW(pB0,6)};pw1=(u32x4){PKW(pB0,8),PKW(pB0,10),PKW(pB0,12),PKW(pB0,14)};pw2=(u32x4){PKW(pB1,0),PKW(pB1,2),PKW(pB1,4),PKW(pB1,6)};pw3=(u32x4){PKW(pB1,8),PKW(pB1,10),PKW(pB1,12),PKW(pB1,14)};
    SBAR(); pv(o,vb0+sl_cur,PAF(0),PAF(1),PAF(2),PAF(3)); }
  #undef PKW
  #undef PAF
  #undef VFR
  #undef PIN
  #undef MX3
  #undef GAPA
  #undef GAPB
  #undef EX
  #undef VRD
  #undef KRD
  #undef STEP
  #undef ENDW
  {auto rr=__builtin_amdgcn_permlane32_swap(__float_as_uint(l_reg),__float_as_uint(l_reg),false,false);l_reg=__uint_as_float(rr[0])+__uint_as_float(rr[1]);}
  if(hi==0)wsf[32+r32]=l_reg;asm volatile("s_waitcnt lgkmcnt(0)":::"memory");
  float rli[16];
  #pragma unroll
  for(int r=0;r<16;++r)rli[r]=__builtin_amdgcn_rcpf(wsf[32+crow(r,hi)]);
  bf16*Ow=O+(rowbase+q0+wid*QBLK)*DM+h*D;
  { bf16*stg=(bf16*)(shm+LDS_OST)+wid*2048;
    #pragma unroll
    for(int r=0;r<16;++r){const int orow=crow(r,hi);
      #pragma unroll
      for(int d0=0;d0<2;++d0)stg[orow*64+d0*32+r32]=__float2bfloat16(o[d0][r]*rli[r]);}
    asm volatile("s_waitcnt lgkmcnt(0)":::"memory");
    #pragma unroll
    for(int i=0;i<4;++i){const int row=i*8+(lane>>3),ch=lane&7; const u32x4 v=*(const u32x4*)(stg+row*64+ch*8); ATTN_STORE16(Ow+(long)row*DM+ch*8,v);} }
  asm volatile("s_waitcnt lgkmcnt(0)\n\ts_barrier":::"memory");
  #undef DMA_K
  #undef DMA_V
  #undef TMAP
  #undef CMASK
  #undef START
  #undef RESC
  #undef ROT
}
#undef SBAR
#undef WAIT_BAR
}

struct Args { const void* in[36]; float* out; unsigned char* ws; int ph_lo, ph_hi; };
typedef __attribute__((address_space(4))) const unsigned char* kptr_t;
__device__ __forceinline__ const void* inp_ptr(int k) {
    kptr_t base = (kptr_t)__builtin_amdgcn_kernarg_segment_ptr();
    asm volatile("" : "+s"(base));
    return *(const void* const __attribute__((address_space(4)))*)(base + 8 * k);
}
#define INP(k) inp_ptr(k)
struct Frame {
    LAS unsigned char* lds;
    int tid, lane, wave, vcu, G;
    unsigned char* ws;
};

__device__ __forceinline__ int rowmap(int kind, int n) {
    if (kind == 1) return (n & ~31) + pg8::invperm32(n & 31);
    if (kind == 2) { const int c = n & 255; return (n & ~255) + 128 * ((c >> 5) & 1) + 32 * (c >> 6) + 16 * ((c >> 2) & 1) + 4 * ((c >> 3) & 3) + (c & 3); }
    if (kind == 3) { const int pn = n >> 7, q = n & 127; return pn * 256 + (q & ~31) + pg8::invperm32(q & 31); }
    return n;
}
__device__ __forceinline__ void conv_item(const float* W, int Nsrc, int k0, int n0, bf16* WT, int dst_ld, int dst_k0, int row_off, int kind, int smode, const float* sv, bool zero, LAS float* scr, int lane) {
    if (!zero) {
        const int rr = lane >> 3, c4 = (lane & 7) * 4;
        f32x4 w[8];
#pragma unroll
        for (int i = 0; i < 8; ++i) w[i] = *(const f32x4*)(W + (size_t)(k0 + 8 * i + rr) * Nsrc + n0 + c4);
#pragma unroll
        for (int i = 0; i < 8; ++i) { const int kk = 8 * i + rr; f32x4 v = w[i];
            if (smode == 1) v = v * sv[k0 + kk]; else if (smode == 2) v = v * (1.0f - sv[k0 + kk]);
            scr[kk * 33 + c4] = v[0]; scr[kk * 33 + c4 + 1] = v[1]; scr[kk * 33 + c4 + 2] = v[2]; scr[kk * 33 + c4 + 3] = v[3]; }
    }
    LDS_WAIT(); asm volatile("" ::: "memory");
    const int c = lane & 7;
#pragma unroll
    for (int j = 0; j < 4; ++j) { const int n = (lane >> 3) + 8 * j; const LAS float* s = scr + (8 * c) * 33 + n;
        v4u o; if (zero) o = (v4u){0u, 0u, 0u, 0u}; else { o.x = pk2(s[0 * 33], s[1 * 33]); o.y = pk2(s[2 * 33], s[3 * 33]); o.z = pk2(s[4 * 33], s[5 * 33]); o.w = pk2(s[6 * 33], s[7 * 33]); }
        *(v4u*)(WT + (size_t)(row_off + rowmap(kind, n0 + n)) * dst_ld + dst_k0 + k0 + 8 * c) = o; }
    LDS_WAIT(); asm volatile("" ::: "memory");
}
__device__ __forceinline__ void conv_mat(int& cursor, int gw, int NGW, const float* W, int K, int N, int Nsrc, bf16* WT, int dst_ld, int dst_k0, int row_off, int kind, int smode, const float* sv, LAS float* scr, int lane) {
    const int nblk = N / 32, ni = (K / 64) * nblk;
    const int first = cursor + (((gw - cursor) % NGW) + NGW) % NGW;
    for (int it = first; it < cursor + ni; it += NGW) { const int li = it - cursor, kb = li / nblk, nb = li % nblk;
        conv_item(W, Nsrc, 64 * kb, 32 * nb, WT, dst_ld, dst_k0, row_off, kind, smode, sv, false, scr, lane); }
    cursor += ni;
}

__device__ __forceinline__ float row_load_rinv(const float* xrow, int lane, f32x4 (&v)[4]) {
    const f32x4* xr = (const f32x4*)xrow + lane; float s = 0.f;
#pragma unroll
    for (int j = 0; j < 4; ++j) { v[j] = xr[64 * j]; s += (v[j][0] * v[j][0] + v[j][1] * v[j][1]) + (v[j][2] * v[j][2] + v[j][3] * v[j][3]); }
    return 1.0f / sqrtf(wave_sum(s) * (1.0f / DM) + RMS_EPS);
}
__device__ __forceinline__ void row_store_bf16(bf16* orow, int lane, const f32x4 (&v)[4]) {
    unsigned long long* o8 = (unsigned long long*)orow + lane;
#pragma unroll
    for (int j = 0; j < 4; ++j) o8[64 * j] = (unsigned long long)pk2(v[j][0], v[j][1]) | ((unsigned long long)pk2(v[j][2], v[j][3]) << 32);
}
__device__ __forceinline__ void load_vec(const float* p, int lane, f32x4 (&v)[4]) {
#pragma unroll
    for (int j = 0; j < 4; ++j) v[j] = ((const f32x4*)p + lane)[64 * j];
}

__device__ __forceinline__ void p0_prologue(Frame& F, const Args& a) {
    unsigned char* ws = F.ws;
    LAS float* scr = (LAS float*)(F.lds + F.wave * 16384);
    const int gw = F.vcu * NWAVES + F.wave, NGW = F.G * NWAVES, lane = F.lane;
    const float* mu = (const float*)INP(7);
    {
        int cur = 0;
        const float* wrkv = (const float*)INP(19);
        bf16* WRKV = (bf16*)(ws + WS_WRKV); bf16* WLD = (bf16*)(ws + WS_WLD); bf16* WLU = (bf16*)(ws + WS_WLU);
        conv_mat(cur, gw, NGW, wrkv, DM, DM, DM, WRKV, DM, 0, 0, 1, 0, nullptr, scr, lane);
        conv_mat(cur, gw, NGW, wrkv + (size_t)DM * DM, DM, DM, DM, WRKV, DM, 0, DM, 1, 0, nullptr, scr, lane);
        conv_mat(cur, gw, NGW, wrkv + (size_t)2 * DM * DM, DM, DM, DM, WRKV, DM, 0, 2 * DM, 1, 0, nullptr, scr, lane);
        conv_mat(cur, gw, NGW, (const float*)INP(22), DM, DM, DM, (bf16*)(ws + WS_WRWO), DM, 0, 0, 1, 0, nullptr, scr, lane);
        conv_mat(cur, gw, NGW, (const float*)INP(9), DM, 64, 64, WLD, 2048, 0, 0, 1, 2, mu + 1 * DM, scr, lane);
        conv_mat(cur, gw, NGW, (const float*)INP(9), DM, 64, 64, WLD, 2048, 1024, 0, 1, 1, mu + 1 * DM, scr, lane);
        conv_mat(cur, gw, NGW, (const float*)INP(12), DM, 64, 64, WLD, 2048, 0, 64, 1, 2, mu + 4 * DM, scr, lane);
        conv_mat(cur, gw, NGW, (const float*)INP(12), DM, 64, 64, WLD, 2048, 1024, 64, 1, 1, mu + 4 * DM, scr, lane);
        conv_mat(cur, gw, NGW, (const float*)INP(14), DM, 128, 128, WLD, 2048, 0, 128, 1, 2, mu + 5 * DM, scr, lane);
        conv_mat(cur, gw, NGW, (const float*)INP(14), DM, 128, 128, WLD, 2048, 1024, 128, 1, 1, mu + 5 * DM, scr, lane);
        conv_mat(cur, gw, NGW, (const float*)INP(10), 64, DM, DM, WLU, 256, 0, 0, 1, 0, nullptr, scr, lane);
        conv_mat(cur, gw, NGW, (const float*)INP(13), 64, DM, DM, WLU, 256, 64, DM, 1, 0, nullptr, scr, lane);
        conv_mat(cur, gw, NGW, (const float*)INP(15), 128, DM, DM, WLU, 256, 128, 2 * DM, 1, 0, nullptr, scr, lane);
        {
            const int zfirst = cur + (((gw - cur) % NGW) + NGW) % NGW, nz = 3 * 32 * 4;
            for (int it = zfirst; it < cur + nz; it += NGW) { const int li = it - cur, kb = li & 3, nb = (li >> 2) & 31, rg = li >> 7;
                const bool has = (rg == 0 && kb == 0) || (rg == 1 && kb == 1) || (rg == 2 && kb >= 2);
                if (!has) conv_item(nullptr, 0, 64 * kb, 32 * nb, WLU, 256, 0, rg * DM, 0, 0, nullptr, true, scr, lane); }
            cur += nz;
        }
        conv_mat(cur, gw, NGW, (const float*)INP(23), DM, 2 * DM, 3 * DM, (bf16*)(ws + WS_WMBQKV), DM, 0, 0, 2, 1, (const float*)INP(3) + DM, scr, lane);
        conv_mat(cur, gw, NGW, (const float*)INP(23) + 2 * DM, DM, DM, 3 * DM, (bf16*)(ws + WS_WMBQKV), DM, 0, 2 * DM, 1, 1, (const float*)INP(3) + DM, scr, lane);
        conv_mat(cur, gw, NGW, (const float*)INP(24), DM, DM, DM, (bf16*)(ws + WS_WMBO), DM, 0, 0, 1, 0, nullptr, scr, lane);
#pragma unroll
        for (int l = 0; l < 2; ++l) {
            conv_mat(cur, gw, NGW, (const float*)INP(26) + (size_t)l * DM * 2 * DM, DM, DM, 2 * DM, (bf16*)(ws + WS_WMXK) + (size_t)l * DM * DM, DM, 0, 0, 1, 0, nullptr, scr, lane);
            conv_mat(cur, gw, NGW, (const float*)INP(26) + (size_t)l * DM * 2 * DM + DM, DM, DM, 2 * DM, (bf16*)(ws + WS_WMXV) + (size_t)l * DM * DM, DM, 0, 0, 1, 0, nullptr, scr, lane);
            conv_mat(cur, gw, NGW, (const float*)INP(27) + (size_t)l * DM * DM, DM, DM, DM, (bf16*)(ws + WS_WMXO) + (size_t)l * DM * DM, DM, 0, 0, 1, 0, nullptr, scr, lane);
        }
    }
    {
        for (int r = gw; r < 2 * DM; r += NGW) { const int l = r >> 10, k = r & 1023; f32x4 v[4]; load_vec((const float*)INP(25) + (size_t)r * DM, lane, v);
            const float gk = ((const float*)INP(4))[l * DM + k];
#pragma unroll
            for (int j = 0; j < 4; ++j) v[j] = v[j] * gk;
            row_store_bf16((bf16*)(ws + WS_WMXQ) + (size_t)r * DM, lane, v); }
    }
    {
        const float* mem = (const float*)INP(1); const float* g = (const float*)INP(5);
        f32x4 g0[4], g1[4]; load_vec(g, lane, g0); load_vec(g + DM, lane, g1);
        for (int r = gw; r < NMEM; r += NGW) { f32x4 v[4]; const float ri = row_load_rinv(mem + (size_t)r * DM, lane, v); f32x4 o[4];
#pragma unroll
            for (int j = 0; j < 4; ++j) o[j] = v[j] * ri * g0[j];
            row_store_bf16((bf16*)(ws + WS_MEMN) + (size_t)r * DM, lane, o);
#pragma unroll
            for (int j = 0; j < 4; ++j) o[j] = v[j] * ri * g1[j];
            row_store_bf16((bf16*)(ws + WS_MEMN) + (size_t)(NMEM + r) * DM, lane, o); }
    }
    {
        const int* pos = (const int*)INP(2); f32x2* tab = (f32x2*)(ws + WS_ROPE);
        const float inv = powf(10000.0f, -(float)(lane & 31) * 2.0f / 64.0f);
        for (int i = gw * 64 + lane; i < NTOK * 32; i += NGW * 64) { const int row = i >> 5;
            const float ang = (float)pos[row] * inv; float sn, cs; sincosf(ang, &sn, &cs);
            tab[i] = (f32x2){cs, sn}; }
    }
    {
        const float* x = (const float*)INP(0); const float* g = (const float*)INP(3);
        bf16* XR = (bf16*)(ws + ARENA(0)); bf16* XK = (bf16*)(ws + ARENA(1)); bf16* XV = (bf16*)(ws + ARENA(2)); bf16* HP = (bf16*)(ws + ARENA(6));
        f32x4 gv[4], mr[4], mk[4], mv[4]; load_vec(g, lane, gv); load_vec(mu + 0 * DM, lane, mr); load_vec(mu + 2 * DM, lane, mk); load_vec(mu + 3 * DM, lane, mv);
        for (int ch = gw; ch < NTOK / 16; ch += NGW) {
            const int r0 = ch * 16, b = r0 / SEQ, t0 = r0 % SEQ;
            f32x4 prev[4];
            if (t0 == 0) {
#pragma unroll
                for (int j = 0; j < 4; ++j) prev[j] = (f32x4){0.f, 0.f, 0.f, 0.f};
                row_store_bf16(HP + (size_t)b * (SEQ + 1) * DM, lane, prev);
            } else { f32x4 v[4]; const float ri = row_load_rinv(x + (size_t)(r0 - 1) * DM, lane, v);
#pragma unroll
                for (int j = 0; j < 4; ++j) prev[j] = v[j] * ri * gv[j]; }
            f32x4 nv[4], nw[4], nz[4]; load_vec(x + (size_t)r0 * DM, lane, nv); load_vec(x + (size_t)(r0 + 1) * DM, lane, nw); load_vec(x + (size_t)(r0 + 2) * DM, lane, nz);
#define P0_ROW(BUF, i_) do { const int r = r0 + (i_); f32x4 v[4], h[4], o[4]; float sq = 0.f; \
                _Pragma("unroll") for (int j = 0; j < 4; ++j) { v[j] = BUF[j]; sq += (v[j][0] * v[j][0] + v[j][1] * v[j][1]) + (v[j][2] * v[j][2] + v[j][3] * v[j][3]); } \
                if ((i_) + 3 < 16) load_vec(x + (size_t)(r + 3) * DM, lane, BUF); \
                const float ri = 1.0f / sqrtf(wave_sum(sq) * (1.0f / DM) + RMS_EPS); \
                _Pragma("unroll") for (int j = 0; j < 4; ++j) h[j] = v[j] * ri * gv[j]; \
                row_store_bf16(HP + ((size_t)b * (SEQ + 1) + 1 + t0 + (i_)) * DM, lane, h); \
                _Pragma("unroll") for (int j = 0; j < 4; ++j) o[j] = h[j] + (prev[j] - h[j]) * mr[j]; \
                row_store_bf16(XR + (size_t)r * DM, lane, o); \
                _Pragma("unroll") for (int j = 0; j < 4; ++j) o[j] = h[j] + (prev[j] - h[j]) * mk[j]; \
                row_store_bf16(XK + (size_t)r * DM, lane, o); \
                _Pragma("unroll") for (int j = 0; j < 4; ++j) o[j] = h[j] + (prev[j] - h[j]) * mv[j]; \
                row_store_bf16(XV + (size_t)r * DM, lane, o); \
                _Pragma("unroll") for (int j = 0; j < 4; ++j) prev[j] = h[j]; } while (0)
            for (int i = 0; i < 15; i += 3) { P0_ROW(nv, i); P0_ROW(nw, i + 1); P0_ROW(nz, i + 2); }
            P0_ROW(nv, 15);
#undef P0_ROW
        }
    }
}

__device__ __forceinline__ void norm_rows(Frame& F, const float* X, const float* g, bf16* out) {
    const int gw = F.vcu * NWAVES + F.wave, NGW = F.G * NWAVES, lane = F.lane;
    f32x4 gv[4]; load_vec(g, lane, gv);
    for (int r = gw; r < NTOK; r += NGW) { f32x4 v[4]; const float ri = row_load_rinv(X + (size_t)r * DM, lane, v);
#pragma unroll
        for (int j = 0; j < 4; ++j) v[j] = v[j] * ri * gv[j];
        row_store_bf16(out + (size_t)r * DM, lane, v); }
}
__device__ __forceinline__ void combine_rows(Frame& F, bf16* X, const unsigned char* Y, const float* g, float* RN, float* OUT, bool final) {
    const int gw = F.vcu * NWAVES + F.wave, NGW = F.G * NWAVES, lane = F.lane;
    f32x4 gv[4]; load_vec(g, lane, gv);
    unsigned long long xa[4], xb[4]; unsigned ya0[4], ya1[4], yb0[4], yb1[4];
#define CB_LOAD(XB, Y0B, Y1B, r_) do { const unsigned long long* xr = (const unsigned long long*)(X + (size_t)(r_) * DM) + lane; \
        const unsigned* y0 = (const unsigned*)(Y + (size_t)(2 * (r_)) * DM) + lane; const unsigned* y1 = (const unsigned*)(Y + (size_t)(2 * (r_) + 1) * DM) + lane; \
        _Pragma("unroll") for (int j = 0; j < 4; ++j) { XB[j] = xr[64 * j]; Y0B[j] = y0[64 * j]; Y1B[j] = y1[64 * j]; } } while (0)
#define CB_ROW(XB, Y0B, Y1B, r_) do { f32x4 v[4]; float s = 0.f; \
        _Pragma("unroll") for (int j = 0; j < 4; ++j) { const unsigned long long x = XB[j]; const int a = (int)Y0B[j], b = (int)Y1B[j]; \
            v[j][0] = bflo((unsigned)x) + (__builtin_amdgcn_cvt_f32_fp8(a, 0) + __builtin_amdgcn_cvt_f32_fp8(b, 0)) * (1.0f / Y_SCALE); \
            v[j][1] = bfhi((unsigned)x) + (__builtin_amdgcn_cvt_f32_fp8(a, 1) + __builtin_amdgcn_cvt_f32_fp8(b, 1)) * (1.0f / Y_SCALE); \
            v[j][2] = bflo((unsigned)(x >> 32)) + (__builtin_amdgcn_cvt_f32_fp8(a, 2) + __builtin_amdgcn_cvt_f32_fp8(b, 2)) * (1.0f / Y_SCALE); \
            v[j][3] = bfhi((unsigned)(x >> 32)) + (__builtin_amdgcn_cvt_f32_fp8(a, 3) + __builtin_amdgcn_cvt_f32_fp8(b, 3)) * (1.0f / Y_SCALE); \
            s += (v[j][0] * v[j][0] + v[j][1] * v[j][1]) + (v[j][2] * v[j][2] + v[j][3] * v[j][3]); } \
        if ((r_) + 2 * NGW < NTOK) CB_LOAD(XB, Y0B, Y1B, (r_) + 2 * NGW); \
        const float ri = 1.0f / sqrtf(wave_sum(s) * (1.0f / DM) + RMS_EPS); \
        if (final) { f32x4* ow = (f32x4*)(OUT + (size_t)(r_) * DM) + lane; \
            _Pragma("unroll") for (int j = 0; j < 4; ++j) ow[64 * j] = v[j] * ri * gv[j]; \
        } else { \
            row_store_bf16(X + (size_t)(r_) * DM, lane, v); \
            if (lane == 0) RN[r_] = ri;                                     \
        } } while (0)
    CB_LOAD(xa, ya0, ya1, gw); CB_LOAD(xb, yb0, yb1, gw + NGW);
    for (int r = gw; r < NTOK; r += 2 * NGW) { CB_ROW(xa, ya0, ya1, r); CB_ROW(xb, yb0, yb1, r + NGW); }
#undef CB_LOAD
#undef CB_ROW
}

constexpr int SC_TC = 32;
constexpr int SC_KK = 0, SC_DD = 8192, SC_AK = 16384, SC_KP = 24576, SC_RR = 32768, SC_VV = 40960, SC_OB = 49152, SC_BS = 57344;
__device__ __forceinline__ void rwkv_scan(Frame& F, const Args& a, const bf16* R, const bf16* K, const bf16* V, const bf16* LD, const bf16* AA, const bf16* GG, bf16* Z) {
    const int bh = F.vcu; if (bh >= BATCH * NHEAD) return;
    const int b = bh / NHEAD, h = bh % NHEAD, tid = F.tid;
    LAS unsigned char* lds = F.lds;
    const float* kkw = (const float*)INP(16); const float* kaw = (const float*)INP(17); const float* rkw = (const float*)INP(18);
    const float* lng = (const float*)INP(20); const float* lnb = (const float*)INP(21);
    const int tl = tid >> 4, c4 = (tid & 15) * 4, col = h * HD + c4;
    const f32x4 kk_w = *(const f32x4*)(kkw + col), ka_w = *(const f32x4*)(kaw + col), rk_w = *(const f32x4*)(rkw + col), ln_g = *(const f32x4*)(lng + col), ln_b = *(const f32x4*)(lnb + col);
    const int rp = tid >> 4, q4 = (tid & 15) * 4;
    f32x4 S0 = {0.f, 0.f, 0.f, 0.f}, S1 = {0.f, 0.f, 0.f, 0.f};
    const size_t rowb = (size_t)b * SEQ;
    v2u nr, nk, nv, nl, na, ng;
#define SC_LOAD(t0) do { const size_t off = (rowb + (t0) + tl) * DM + col; nr = *(const v2u*)(R + off); nk = *(const v2u*)(K + off); nv = *(const v2u*)(V + off); nl = *(const v2u*)(LD + off); na = *(const v2u*)(AA + off); } while (0)
    SC_LOAD(0);
    for (int ch = 0; ch < SEQ / SC_TC; ++ch) {
        const int t0 = ch * SC_TC;
        {
            const f32x4 r = {bflo(nr.x), bfhi(nr.x), bflo(nr.y), bfhi(nr.y)}, k = {bflo(nk.x), bfhi(nk.x), bflo(nk.y), bfhi(nk.y)}, v = {bflo(nv.x), bfhi(nv.x), bflo(nv.y), bfhi(nv.y)};
            const f32x4 l = {bflo(nl.x), bfhi(nl.x), bflo(nl.y), bfhi(nl.y)}, av = {bflo(na.x), bfhi(na.x), bflo(na.y), bfhi(na.y)};
            f32x4 kk = k * kk_w; const float n2 = row16_sum((kk[0] * kk[0] + kk[1] * kk[1]) + (kk[2] * kk[2] + kk[3] * kk[3]));
            kk = kk * (1.0f / fmaxf(sqrtf(n2), 1e-12f));
            const f32x4 kp = k * (1.0f + (av - 1.0f) * ka_w), ak = kk * av;
            f32x4 d; d[0] = __expf(l[0]); d[1] = __expf(l[1]); d[2] = __expf(l[2]); d[3] = __expf(l[3]);
            const f32x4 rb = r * kp * rk_w; const float bs = row16_sum((rb[0] + rb[1]) + (rb[2] + rb[3]));
            const int o = (tl * 64 + c4) * 4;
            *(LAS f32x4*)(lds + SC_KK + o) = kk; *(LAS f32x4*)(lds + SC_DD + o) = d; *(LAS f32x4*)(lds + SC_AK + o) = ak; *(LAS f32x4*)(lds + SC_KP + o) = kp; *(LAS f32x4*)(lds + SC_RR + o) = r; *(LAS f32x4*)(lds + SC_VV + o) = v;
            if ((tid & 15) == 0) *(LAS float*)(lds + SC_BS + tl * 4) = bs;
        }
        __syncthreads();
        if (ch + 1 < SEQ / SC_TC) SC_LOAD(t0 + SC_TC);
        ng = *(const v2u*)(GG + (rowb + t0 + tl) * DM + col);
        {
#define SC_OPS(t, KK, D_, AK, KP, R_, VV) do { const int o_ = ((t) * 64 + q4) * 4; KK = *(const LAS f32x4*)(lds + SC_KK + o_); D_ = *(const LAS f32x4*)(lds + SC_DD + o_); AK = *(const LAS f32x4*)(lds + SC_AK + o_); \
            KP = *(const LAS f32x4*)(lds + SC_KP + o_); R_ = *(const LAS f32x4*)(lds + SC_RR + o_); VV = *(const LAS f32x2*)(lds + SC_VV + ((t) * 64 + 2 * rp) * 4); } while (0)
            f32x4 kk, d, ak, kp, r; f32x2 vv;
            SC_OPS(0, kk, d, ak, kp, r, vv);
            for (int t4 = 0; t4 < SC_TC; t4 += 4) {
                float po0[4], po1[4];
#pragma unroll
                for (int u = 0; u < 4; ++u) {
                    const int t = t4 + u;
                    f32x4 nkk = kk, nd = d, nak = ak, nkp = kp, nr = r; f32x2 nvv = vv;
                    if (t + 1 < SC_TC) SC_OPS(t + 1, nkk, nd, nak, nkp, nr, nvv);
                    const float sk0 = row16_sum((S0[0] * kk[0] + S0[1] * kk[1]) + (S0[2] * kk[2] + S0[3] * kk[3]));
                    const float sk1 = row16_sum((S1[0] * kk[0] + S1[1] * kk[1]) + (S1[2] * kk[2] + S1[3] * kk[3]));
                    S0 = S0 * d + (kp * vv[0] - ak * sk0);
                    S1 = S1 * d + (kp * vv[1] - ak * sk1);
                    po0[u] = (S0[0] * r[0] + S0[1] * r[1]) + (S0[2] * r[2] + S0[3] * r[3]);
                    po1[u] = (S1[0] * r[0] + S1[1] * r[1]) + (S1[2] * r[2] + S1[3] * r[3]);
                    kk = nkk; d = nd; ak = nak; kp = nkp; r = nr; vv = nvv;
                }
#pragma unroll
                for (int u = 0; u < 4; ++u) { po0[u] = row16_sum(po0[u]); po1[u] = row16_sum(po1[u]); }
                if ((tid & 15) == 0) {
#pragma unroll
                    for (int u = 0; u < 4; ++u) *(LAS f32x2*)(lds + SC_OB + ((t4 + u) * 64 + 2 * rp) * 4) = (f32x2){po0[u], po1[u]};
                }
            }
#undef SC_OPS
        }
        __syncthreads();
        {
            const f32x4 o = *(const LAS f32x4*)(lds + SC_OB + (tl * 64 + c4) * 4), v = *(const LAS f32x4*)(lds + SC_VV + (tl * 64 + c4) * 4);
            const float bs = *(const LAS float*)(lds + SC_BS + tl * 4);
            const float mean = row16_sum((o[0] + o[1]) + (o[2] + o[3])) * (1.0f / 64.0f);
            const f32x4 dlt = o - mean; const float var = row16_sum((dlt[0] * dlt[0] + dlt[1] * dlt[1]) + (dlt[2] * dlt[2] + dlt[3] * dlt[3])) * (1.0f / 64.0f);
            const float rs = 1.0f / sqrtf(var + GN_EPS);
            const f32x4 g = {bflo(ng.x), bfhi(ng.x), bflo(ng.y), bfhi(ng.y)};
            const f32x4 z = (dlt * rs * ln_g + ln_b + v * bs) * g;
            v2u w; w.x = pk2(z[0], z[1]); w.y = pk2(z[2], z[3]);
            *(v2u*)(Z + (rowb + t0 + tl) * DM + col) = w;
        }
        __syncthreads();
    }
#undef SC_LOAD
}

constexpr int CS_P = 72, CS_SLOT = 64 * CS_P * 2;
constexpr int CS_VN = 16 * CS_SLOT;
constexpr int CS_WL = 17 * CS_SLOT, CS_BS = CS_WL + 256, CS_CST = CS_WL + 1024;
enum { SL_S0H = 0, SL_S0L = 1, SL_AT = 2, SL_BT = 3, SL_KT = 4, SL_RT = 5, SL_ATT = 6, SL_BTT = 7, SL_KTT = 8, SL_VT = 9 };
typedef LAS unsigned char* ldsp_t;
template <bool SWB = false, bool SWA = false>
__device__ __forceinline__ void mm_acc(f32x4 (&acc)[2], ldsp_t Bop, ldsp_t Aop, int w, int fr, int fq) {
    const int tj = w >> 1, ti0 = 2 * (w & 1);
#pragma unroll
    for (int ks = 0; ks < 2; ++ks) {
        const int rb = 16 * tj + fr, cb = SWB ? ((4 * ks + fq) ^ ((rb >> 3) & 7)) : (4 * ks + fq);
        const bf16x8 b = *(const LAS bf16x8*)(Bop + (rb * CS_P + 8 * cb) * 2);
#pragma unroll
        for (int u = 0; u < 2; ++u) { const int ra = 16 * (ti0 + u) + fr, ca = SWA ? ((4 * ks + fq) ^ ((ra >> 3) & 7)) : (4 * ks + fq);
            const bf16x8 a = *(const LAS bf16x8*)(Aop + (ra * CS_P + 8 * ca) * 2);
            acc[u] = __builtin_amdgcn_mfma_f32_16x16x32_bf16(a, b, acc[u], 0, 0, 0); }
    }
}
template <bool SW = false>
__device__ __forceinline__ void ld_b(bf16x8 (&b)[2], ldsp_t Bop, int w, int fr, int fq) {
    const int rb = 16 * (w >> 1) + fr;
#pragma unroll
    for (int ks = 0; ks < 2; ++ks) { const int cb = SW ? ((4 * ks + fq) ^ ((rb >> 3) & 7)) : (4 * ks + fq); b[ks] = *(const LAS bf16x8*)(Bop + (rb * CS_P + 8 * cb) * 2); }
}
template <bool SW = false>
__device__ __forceinline__ void ld_a(bf16x8 (&a)[2][2], ldsp_t Aop, int w, int fr, int fq) {
#pragma unroll
    for (int ks = 0; ks < 2; ++ks)
#pragma unroll
        for (int u = 0; u < 2; ++u) { const int ra = 16 * (2 * (w & 1) + u) + fr, ca = SW ? ((4 * ks + fq) ^ ((ra >> 3) & 7)) : (4 * ks + fq); a[ks][u] = *(const LAS bf16x8*)(Aop + (ra * CS_P + 8 * ca) * 2); }
}
__device__ __forceinline__ void mma(f32x4 (&acc)[2], const bf16x8 (&b)[2], const bf16x8 (&a)[2][2]) {
#pragma unroll
    for (int ks = 0; ks < 2; ++ks)
#pragma unroll
        for (int u = 0; u < 2; ++u) acc[u] = __builtin_amdgcn_mfma_f32_16x16x32_bf16(a[ks][u], b[ks], acc[u], 0, 0, 0);
}
__device__ __forceinline__ void cs_store(ldsp_t dst, int r, int c0, const f32x4& v) { v2u w; w.x = cvt2(v[0], v[1]); w.y = cvt2(v[2], v[3]); *(LAS v2u*)(dst + (r * CS_P + c0) * 2) = w; }
__device__ __forceinline__ f32x4 cs_load(ldsp_t src, int r, int c0) { const v2u w = *(const LAS v2u*)(src + (r * CS_P + c0) * 2); return (f32x4){bflo(w.x), bfhi(w.x), bflo(w.y), bfhi(w.y)}; }
#define CS_SL(i) (lds + (i) * CS_SLOT)
#define CS_ZERO(a) do { a[0] = (f32x4){0.f, 0.f, 0.f, 0.f}; a[1] = a[0]; } while (0)
#define CS_FOR_U _Pragma("unroll") for (int u = 0; u < 2; ++u)
#define CS_BAR() do { LDS_WAIT(); __builtin_amdgcn_s_barrier(); asm volatile("" ::: "memory"); } while (0)
template <int CTRL> __device__ __forceinline__ float dppf8(float v) { return dppf<CTRL>(v); }
__device__ __forceinline__ float row8_sum(float v) { v += dppf<0xB1>(v); v += dppf<0x4E>(v); v += dppf<0x141>(v); return v; }
__device__ __forceinline__ void rwkv_scan_chunked(Frame& F, const bf16* R, const bf16* K, const bf16* V, const bf16* LO, const bf16* WLU, const float* w0p, const float* a0p, bf16* Z) {
    const int bh = F.vcu; if (bh >= BATCH * NHEAD) return;
    const int b = bh / NHEAD, h = bh % NHEAD;
    int tid = threadIdx.x; asm volatile("" : "+v"(tid));
    const int lane = tid & 63, w = __builtin_amdgcn_readfirstlane(tid >> 6), fr = lane & 15, fq = lane >> 4;
    ldsp_t lds = F.lds;
    const int tj = w >> 1, ti0 = 2 * (w & 1), er = 16 * tj + fr;
    const int tl = tid >> 3, c8 = (tid & 7) * 8, col = h * HD + c8;
    const float* kkw = (const float*)INP(16); const float* kaw = (const float*)INP(17); const float* rkw = (const float*)INP(18);
    const float* lng = (const float*)INP(20); const float* lnb = (const float*)INP(21);
    if (tid < 64) { LAS float* cst = (LAS float*)(lds + CS_CST); cst[tid] = kkw[h * HD + tid]; cst[64 + tid] = kaw[h * HD + tid]; cst[128 + tid] = rkw[h * HD + tid]; cst[192 + tid] = lng[h * HD + tid]; cst[256 + tid] = lnb[h * HD + tid]; }
#define CS_CLD(arr, j) do { const f32x4 c0_ = *(const LAS f32x4*)(lds + CS_CST + ((j) * 64 + c8) * 4), c1_ = *(const LAS f32x4*)(lds + CS_CST + ((j) * 64 + c8 + 4) * 4); \
                            arr[0] = c0_[0]; arr[1] = c0_[1]; arr[2] = c0_[2]; arr[3] = c0_[3]; arr[4] = c1_[0]; arr[5] = c1_[1]; arr[6] = c1_[2]; arr[7] = c1_[3]; } while (0)
    const size_t rowb = (size_t)b * SEQ;
    for (int i = tid; i < 2 * CS_SLOT / 4; i += 512) ((LAS unsigned*)lds)[i] = 0u;
    v4u nr, nk, nv;
#define CS_LOAD(t0) do { const size_t off = (rowb + (t0) + tl) * DM + col; nr = *(const v4u*)(R + off); nk = *(const v4u*)(K + off); nv = *(const v4u*)(V + off); } while (0)
    f32x4 w0v[2], a0v[2];
#pragma unroll
    for (int u = 0; u < 2; ++u) { w0v[u] = *(const f32x4*)(w0p + h * HD + 16 * (ti0 + u) + 4 * fq); a0v[u] = *(const f32x4*)(a0p + h * HD + 16 * (ti0 + u) + 4 * fq); }
#define CS_UNPK(PK_, o) do { o[0] = bflo((PK_)[0]); o[1] = bfhi((PK_)[0]); o[2] = bflo((PK_)[1]); o[3] = bfhi((PK_)[1]); o[4] = bflo((PK_)[2]); o[5] = bfhi((PK_)[2]); o[6] = bflo((PK_)[3]); o[7] = bfhi((PK_)[3]); } while (0)
    const int st_t = tid >> 3, st_part = tid & 7, st_tile = tid >> 7, st_k = (tid >> 1) & 63, st_hf = tid & 1;
    const ldsp_t st_ldst = CS_SL(2 + (st_part >> 1)) + (st_t * CS_P + (st_part & 1) * 32) * 2;
    const ldsp_t st_wdst = CS_SL(6 + st_tile) + (st_k * CS_P + 32 * st_hf) * 2;
    v4u sl0, sl1, sl2, sl3, sw0, sw1, sw2, sw3;
    const v4u* st_wsrc = (const v4u*)(WLU + (size_t)((st_tile < 2 ? st_tile : 2) * DM + rowmap(1, h * HD + st_k)) * 256 + 64 * st_tile + 32 * st_hf);
#define CS_STAGE_LD(t0) do { const v4u* src = (const v4u*)(LO + (rowb + (t0) + st_t) * 256 + 32 * st_part); sl0 = src[0]; sl1 = src[1]; sl2 = src[2]; sl3 = src[3]; \
                              sw0 = st_wsrc[0]; sw1 = st_wsrc[1]; sw2 = st_wsrc[2]; sw3 = st_wsrc[3]; } while (0)
#define CS_STAGE_ST() do { *(LAS v4u*)(st_ldst) = sl0; *(LAS v4u*)(st_ldst + 16) = sl1; *(LAS v4u*)(st_ldst + 32) = sl2; *(LAS v4u*)(st_ldst + 48) = sl3; \
                           *(LAS v4u*)(st_wdst) = sw0; *(LAS v4u*)(st_wdst + 16) = sw1; *(LAS v4u*)(st_wdst + 32) = sw2; *(LAS v4u*)(st_wdst + 48) = sw3; } while (0)
    CS_STAGE_LD(0); CS_STAGE_ST();
    CS_LOAD(0);
    for (int ch = 0; ch < SEQ / 64; ++ch) {
        const int t0 = ch * 64;
        LAS float* cw = (LAS float*)CS_SL(10);
        float r_[8], k_[8], v_[8], a_[8], gg[8];
        CS_UNPK(nr, r_); CS_UNPK(nk, k_); CS_UNPK(nv, v_);
        const v4u nv_keep = nv;
        CS_BAR();
        {
            f32x4 aw[2], aa[2], ag[2];
            CS_ZERO(aw); mm_acc(aw, CS_SL(2), CS_SL(6), w, fr, fq);
            CS_ZERO(aa); mm_acc(aa, CS_SL(3), CS_SL(7), w, fr, fq);
            CS_ZERO(ag); mm_acc(ag, CS_SL(4), CS_SL(8), w, fr, fq); mm_acc(ag, CS_SL(5), CS_SL(9), w, fr, fq);
            CS_FOR_U { const int c0 = 16 * (ti0 + u) + 4 * fq; f32x4 lv, av;
#pragma unroll
                for (int i = 0; i < 4; ++i) { float l = -0.6065306597126334f * sigmoidf_(aw[u][i] + w0v[u][i]);
                    l += dppf<0x111>(l); l += dppf<0x112>(l); l += dppf<0x114>(l); l += dppf<0x118>(l);
                    lv[i] = l; av[i] = sigmoidf_(aa[u][i] + a0v[u][i]); }
                *(LAS f32x4*)(CS_SL(10) + (er * 64 + c0) * 4) = lv; *(LAS f32x4*)(CS_SL(12) + (er * 64 + c0) * 4) = av; *(LAS f32x4*)(CS_SL(14) + (er * 64 + c0) * 4) = ag[u]; }
            CS_BAR();
            const LAS float* af = (const LAS float*)CS_SL(12) + tl * 64 + c8; const LAS float* gf = (const LAS float*)CS_SL(14) + tl * 64 + c8;
#pragma unroll
            for (int e = 0; e < 8; ++e) { a_[e] = af[e]; gg[e] = gf[e]; }
        }
        if (ch + 1 < SEQ / 64) CS_LOAD(t0 + 64);
        {
            float kk[8], kp[8], n2 = 0.f, bsum = 0.f, kkw_[8], kaw_[8], rkw_[8];
            CS_CLD(kkw_, 0); CS_CLD(kaw_, 1); CS_CLD(rkw_, 2);
#pragma unroll
            for (int e = 0; e < 8; ++e) { kk[e] = k_[e] * kkw_[e]; n2 += kk[e] * kk[e]; kp[e] = k_[e] * (1.0f + (a_[e] - 1.0f) * kaw_[e]); bsum += r_[e] * kp[e] * rkw_[e]; }
            n2 = row8_sum(n2); bsum = row8_sum(bsum);
            const float inv = 1.0f / fmaxf(sqrtf(n2), 1e-12f);
            f32x4 at0, at1, bt0, bt1, kt0, kt1, rt0, rt1;
            float atv[8], btv[8], ktv[8], rtv[8];
#pragma unroll
            for (int e = 0; e < 8; ++e) {
                const float off = (tl >= 16 ? cw[15 * 64 + c8 + e] : 0.f) + (tl >= 32 ? cw[31 * 64 + c8 + e] : 0.f) + (tl >= 48 ? cw[47 * 64 + c8 + e] : 0.f);
                const float c1 = cw[tl * 64 + c8 + e] + off, c0 = ((tl & 15) ? cw[(tl - 1) * 64 + c8 + e] : 0.f) + off;
                const float kn = kk[e] * inv, ep = __expf(c1), em = __expf(-c1);
                atv[e] = kn * __expf(c0); btv[e] = kn * a_[e] * em; ktv[e] = kp[e] * em; rtv[e] = r_[e] * ep;
                if (tl == 63) ((LAS float*)(lds + CS_WL))[c8 + e] = ep; }
            at0 = (f32x4){atv[0], atv[1], atv[2], atv[3]}; at1 = (f32x4){atv[4], atv[5], atv[6], atv[7]};
            bt0 = (f32x4){btv[0], btv[1], btv[2], btv[3]}; bt1 = (f32x4){btv[4], btv[5], btv[6], btv[7]};
            kt0 = (f32x4){ktv[0], ktv[1], ktv[2], ktv[3]}; kt1 = (f32x4){ktv[4], ktv[5], ktv[6], ktv[7]};
            rt0 = (f32x4){rtv[0], rtv[1], rtv[2], rtv[3]}; rt1 = (f32x4){rtv[4], rtv[5], rtv[6], rtv[7]};
            cs_store(CS_SL(SL_AT), tl, c8, at0); cs_store(CS_SL(SL_AT), tl, c8 + 4, at1);
            cs_store(CS_SL(SL_BT), tl, c8, bt0); cs_store(CS_SL(SL_BT), tl, c8 + 4, bt1);
            cs_store(CS_SL(SL_KT), tl, c8, kt0); cs_store(CS_SL(SL_KT), tl, c8 + 4, kt1);
            cs_store(CS_SL(SL_RT), tl, c8, rt0); cs_store(CS_SL(SL_RT), tl, c8 + 4, rt1);
            *(LAS v4u*)(lds + CS_VN + (tl * CS_P + c8) * 2) = nv_keep;
            const int tsw = (((tl >> 3) ^ (tid & 7)) << 3) | (tl & 7);
#pragma unroll
            for (int e = 0; e < 8; e += 2) {
                const unsigned pa = cvt2(atv[e], atv[e + 1]), pb = cvt2(btv[e], btv[e + 1]), pk = cvt2(ktv[e], ktv[e + 1]), pv = cvt2(v_[e], v_[e + 1]);
                *(LAS unsigned short*)(CS_SL(SL_ATT) + ((c8 + e) * CS_P + tsw) * 2) = (unsigned short)pa; *(LAS unsigned short*)(CS_SL(SL_ATT) + ((c8 + e + 1) * CS_P + tsw) * 2) = (unsigned short)(pa >> 16);
                *(LAS unsigned short*)(CS_SL(SL_BTT) + ((c8 + e) * CS_P + tsw) * 2) = (unsigned short)pb; *(LAS unsigned short*)(CS_SL(SL_BTT) + ((c8 + e + 1) * CS_P + tsw) * 2) = (unsigned short)(pb >> 16);
                *(LAS unsigned short*)(CS_SL(SL_KTT) + ((c8 + e) * CS_P + tsw) * 2) = (unsigned short)pk; *(LAS unsigned short*)(CS_SL(SL_KTT) + ((c8 + e + 1) * CS_P + tsw) * 2) = (unsigned short)(pk >> 16);
                *(LAS unsigned short*)(CS_SL(SL_VT) + ((c8 + e) * CS_P + tsw) * 2) = (unsigned short)pv; *(LAS unsigned short*)(CS_SL(SL_VT) + ((c8 + e + 1) * CS_P + tsw) * 2) = (unsigned short)(pv >> 16); }
            if ((tid & 7) == 0) ((LAS float*)(lds + CS_BS))[tl] = bsum;
        }
        CS_BAR();
        {
            bf16x8 bA[2], bR[2], bB[2], aB[2][2], aK[2][2], aA[2][2];
            ld_b(bA, CS_SL(SL_AT), w, fr, fq); ld_a(aB, CS_SL(SL_BT), w, fr, fq); ld_b(bB, CS_SL(SL_BT), w, fr, fq); ld_a(aA, CS_SL(SL_AT), w, fr, fq);
            ld_a(aK, CS_SL(SL_KT), w, fr, fq); ld_b(bR, CS_SL(SL_RT), w, fr, fq);
            f32x4 pab[2], pba[2], pak[2], prb[2], prk[2];
            CS_ZERO(pab); mma(pab, bA, aB); CS_ZERO(pba); mma(pba, bB, aA); CS_ZERO(pak); mma(pak, bA, aK); CS_ZERO(prb); mma(prb, bR, aB); CS_ZERO(prk); mma(prk, bR, aK);
            CS_FOR_U { const int c0 = 16 * (ti0 + u) + 4 * fq; f32x4 x, t, xt, ak, rb_, rk;
#pragma unroll
                for (int i = 0; i < 4; ++i) { x[i] = (c0 + i < er) ? -pab[u][i] : 0.f; t[i] = x[i] + ((c0 + i == er) ? 1.f : 0.f); xt[i] = (c0 + i > er) ? -pba[u][i] : 0.f;
                    ak[i] = (c0 + i < er) ? pak[u][i] : 0.f; rb_[i] = (c0 + i <= er) ? prb[u][i] : 0.f; rk[i] = (c0 + i <= er) ? prk[u][i] : 0.f; }
                cs_store(CS_SL(10), er, c0, x); cs_store(CS_SL(12), er, c0, t); cs_store(CS_SL(11), er, c0, xt); cs_store(CS_SL(13), er, c0, ak); cs_store(CS_SL(14), er, c0, rb_); cs_store(CS_SL(15), er, c0, rk); }
        }
        CS_BAR();
        f32x4 acc[2], acc2[2];
#define CS_PLAIN(dst, bop, aop) do { CS_ZERO(acc); mm_acc(acc, CS_SL(bop), CS_SL(aop), w, fr, fq); CS_FOR_U cs_store(CS_SL(dst), er, 16 * (ti0 + u) + 4 * fq, acc[u]); } while (0)
#define CS_TUPD(dst, told, xt) do { CS_ZERO(acc); mm_acc(acc, CS_SL(told), CS_SL(xt), w, fr, fq); CS_FOR_U { const int c0 = 16 * (ti0 + u) + 4 * fq; cs_store(CS_SL(dst), er, c0, acc[u] + cs_load(CS_SL(told), er, c0)); } } while (0)
#define CS_SQ(dX, dXT, dT, sX, sXT, sT) do { bf16x8 bX_[2], bXT_[2], bT_[2], aX_[2][2], aXT_[2][2]; f32x4 p1_[2], p2_[2], p3_[2]; \
            ld_b(bX_, CS_SL(sX), w, fr, fq); ld_a(aXT_, CS_SL(sXT), w, fr, fq); ld_b(bXT_, CS_SL(sXT), w, fr, fq); ld_a(aX_, CS_SL(sX), w, fr, fq); ld_b(bT_, CS_SL(sT), w, fr, fq); \
            CS_ZERO(p1_); mma(p1_, bX_, aXT_); CS_ZERO(p2_); mma(p2_, bXT_, aX_); CS_ZERO(p3_); mma(p3_, bT_, aXT_); \
            CS_FOR_U { const int c0 = 16 * (ti0 + u) + 4 * fq; cs_store(CS_SL(dX), er, c0, p1_[u]); cs_store(CS_SL(dXT), er, c0, p2_[u]); cs_store(CS_SL(dT), er, c0, p3_[u] + cs_load(CS_SL(sT), er, c0)); \
                mloc = fmaxf(mloc, fmaxf(fmaxf(fabsf(p1_[u][0]), fabsf(p1_[u][1])), fmaxf(fabsf(p1_[u][2]), fabsf(p1_[u][3])))); } } while (0)
#define CS_PLAINM(dst, bop, aop) do { CS_ZERO(acc); mm_acc(acc, CS_SL(bop), CS_SL(aop), w, fr, fq); CS_FOR_U { cs_store(CS_SL(dst), er, 16 * (ti0 + u) + 4 * fq, acc[u]); \
            mloc = fmaxf(mloc, fmaxf(fmaxf(fabsf(acc[u][0]), fabsf(acc[u][1])), fmaxf(fabsf(acc[u][2]), fabsf(acc[u][3])))); } } while (0)
#define CS_PUBMAX(lev) do { _Pragma("unroll") for (int o_ = 1; o_ < 64; o_ <<= 1) mloc = fmaxf(mloc, __shfl_xor(mloc, o_)); if (lane == 0) xm[((lev) & 1) * 8 + w] = mloc; } while (0)
#define CS_GETMAX(lev) ({ const f32x4 a_ = *(const LAS f32x4*)(xm + ((lev) & 1) * 8), b_ = *(const LAS f32x4*)(xm + ((lev) & 1) * 8 + 4); \
            __builtin_bit_cast(float, __builtin_amdgcn_readfirstlane(__builtin_bit_cast(int, fmaxf(fmaxf(fmaxf(a_[0], a_[1]), fmaxf(a_[2], a_[3])), fmaxf(fmaxf(b_[0], b_[1]), fmaxf(b_[2], b_[3])))))); })
        constexpr float CS_TH = 2.44140625e-4f;
        LAS float* xm = (LAS float*)(lds + CS_BS + 256);
        int tslot = 12; float mloc = 0.f;
        { bf16x8 bX[2], bXT[2], bV[2], aX[2][2], aXT[2][2], aK[2][2]; f32x4 p1[2], p2[2], p3[2];
          ld_b(bX, CS_SL(10), w, fr, fq); ld_a(aXT, CS_SL(11), w, fr, fq); ld_b(bXT, CS_SL(11), w, fr, fq); ld_a(aX, CS_SL(10), w, fr, fq); ld_b<true>(bV, CS_SL(SL_VT), w, fr, fq); ld_a(aK, CS_SL(13), w, fr, fq);
          CS_ZERO(p1); mma(p1, bX, aXT); CS_ZERO(p2); mma(p2, bXT, aX); CS_ZERO(p3); mma(p3, bV, aK);
          CS_FOR_U { const int c0 = 16 * (ti0 + u) + 4 * fq; cs_store(CS_SL(2), er, c0, p1[u]); cs_store(CS_SL(3), er, c0, p2[u]); cs_store(CS_SL(4), er, c0, p3[u]);
              mloc = fmaxf(mloc, fmaxf(fmaxf(fabsf(p1[u][0]), fabsf(p1[u][1])), fmaxf(fabsf(p1[u][2]), fabsf(p1[u][3])))); } }
        CS_PUBMAX(0);
        CS_BAR();
        if (CS_GETMAX(0) >= CS_TH) {
            mloc = 0.f; CS_SQ(10, 11, 13, 2, 3, 12); CS_PUBMAX(1);
            CS_BAR(); tslot = 13;
            if (CS_GETMAX(1) >= CS_TH) {
                mloc = 0.f; CS_SQ(2, 3, 12, 10, 11, 13); CS_PUBMAX(0);
                CS_BAR(); tslot = 12;
                if (CS_GETMAX(0) >= CS_TH) {
                    mloc = 0.f; CS_SQ(10, 11, 13, 2, 3, 12); CS_PUBMAX(1);
                    CS_BAR(); tslot = 13;
                    if (CS_GETMAX(1) >= CS_TH) {
                        mloc = 0.f;
                        { bf16x8 bXT[2], bT[2], aX[2][2], aXT[2][2]; f32x4 p1[2], p2[2];
                          ld_b(bXT, CS_SL(11), w, fr, fq); ld_a(aX, CS_SL(10), w, fr, fq); ld_b(bT, CS_SL(13), w, fr, fq); ld_a(aXT, CS_SL(11), w, fr, fq);
                          CS_ZERO(p1); mma(p1, bXT, aX); CS_ZERO(p2); mma(p2, bT, aXT);
                          CS_FOR_U { const int c0 = 16 * (ti0 + u) + 4 * fq; cs_store(CS_SL(3), er, c0, p1[u]); cs_store(CS_SL(12), er, c0, p2[u] + cs_load(CS_SL(13), er, c0));
                              mloc = fmaxf(mloc, fmaxf(fmaxf(fabsf(p1[u][0]), fabsf(p1[u][1])), fmaxf(fabsf(p1[u][2]), fabsf(p1[u][3])))); } }
                        CS_PUBMAX(0);
                        CS_BAR(); tslot = 12;
                        if (CS_GETMAX(0) >= CS_TH) {
                            CS_TUPD(13, 12, 3);
                            CS_BAR(); tslot = 13;
                        }
                    }
                }
            }
        }
        { bf16x8 bAtt[2], bY[2], aT[2][2];
          ld_a(aT, CS_SL(tslot), w, fr, fq); ld_b<true>(bAtt, CS_SL(SL_ATT), w, fr, fq); ld_b(bY, CS_SL(4), w, fr, fq);
          CS_ZERO(acc); mma(acc, bAtt, aT); CS_ZERO(acc2); mma(acc2, bY, aT);
          CS_FOR_U { const int c0 = 16 * (ti0 + u) + 4 * fq; cs_store(CS_SL(2), er, c0, -acc[u]); cs_store(CS_SL(10), er, c0, -acc2[u]); } }
        CS_BAR();
        { bf16x8 b14[2], b15[2], bBtt[2], a2[2][2], aV[2][2], a10[2][2]; f32x4 pm[2];
          ld_b(b14, CS_SL(14), w, fr, fq); ld_a(a2, CS_SL(2), w, fr, fq); ld_b(b15, CS_SL(15), w, fr, fq); ld_a<true>(aV, CS_SL(SL_VT), w, fr, fq); ld_a(a10, CS_SL(10), w, fr, fq); ld_b<true>(bBtt, CS_SL(SL_BTT), w, fr, fq);
          CS_ZERO(acc); mma(acc, b14, a2); CS_ZERO(acc2); mma(acc2, b15, aV); mma(acc2, b14, a10); CS_ZERO(pm); mma(pm, bBtt, a2);
          const float wl = ((const LAS float*)(lds + CS_WL))[er];
          CS_FOR_U { const int c0 = 16 * (ti0 + u) + 4 * fq; f32x4 m;
#pragma unroll
              for (int i = 0; i < 4; ++i) m[i] = (pm[u][i] + ((c0 + i == er) ? 1.f : 0.f)) * wl;
              cs_store(CS_SL(3), er, c0, acc[u] + cs_load(CS_SL(SL_RT), er, c0)); cs_store(CS_SL(11), er, c0, acc2[u]); cs_store(CS_SL(12), er, c0, m); } }
        CS_BAR();
        if (ch + 1 < SEQ / 64) CS_STAGE_LD(t0 + 64);
        { bf16x8 b3[2], bV[2], b10[2], bH[2], bL[2], aH[2][2], aL[2][2], aK[2][2], aB[2][2], a12[2][2];
          ld_b(b3, CS_SL(3), w, fr, fq); ld_a(aH, CS_SL(SL_S0H), w, fr, fq); ld_a(aL, CS_SL(SL_S0L), w, fr, fq);
          ld_b<true>(bV, CS_SL(SL_VT), w, fr, fq); ld_a<true>(aK, CS_SL(SL_KTT), w, fr, fq); ld_b(b10, CS_SL(10), w, fr, fq); ld_a<true>(aB, CS_SL(SL_BTT), w, fr, fq);
          ld_a(a12, CS_SL(12), w, fr, fq); ld_b(bH, CS_SL(SL_S0H), w, fr, fq); ld_b(bL, CS_SL(SL_S0L), w, fr, fq);
          CS_ZERO(acc); mma(acc, b3, aH); mma(acc, b3, aL);
          CS_ZERO(acc2); mma(acc2, bV, aK); mma(acc2, b10, aB);
          CS_FOR_U { const f32x4 wl4 = *(const LAS f32x4*)(lds + CS_WL + (16 * (ti0 + u) + 4 * fq) * 4); acc2[u] = acc2[u] * wl4; }
          mma(acc2, bH, a12); mma(acc2, bL, a12);
          CS_FOR_U { const int c0 = 16 * (ti0 + u) + 4 * fq; *(LAS f32x4*)(CS_SL(13) + (er * 64 + c0) * 4) = acc[u] + cs_load(CS_SL(11), er, c0); } }
        CS_BAR();
        CS_FOR_U { const int c0 = 16 * (ti0 + u) + 4 * fq; f32x4 hi, lo;
#pragma unroll
            for (int i = 0; i < 4; i += 2) { const unsigned ph = cvt2(acc2[u][i], acc2[u][i + 1]); hi[i] = bflo(ph); hi[i + 1] = bfhi(ph); lo[i] = acc2[u][i] - hi[i]; lo[i + 1] = acc2[u][i + 1] - hi[i + 1]; }
            cs_store(CS_SL(SL_S0H), er, c0, hi); cs_store(CS_SL(SL_S0L), er, c0, lo); }
        if (ch + 1 < SEQ / 64) CS_STAGE_ST();
        {
            const LAS float* ob = (const LAS float*)CS_SL(13) + tl * 64 + c8;
            const f32x4 o0 = *(const LAS f32x4*)ob, o1 = *(const LAS f32x4*)(ob + 4);
            const v4u vw = *(const LAS v4u*)(lds + CS_VN + (tl * CS_P + c8) * 2);
            const float bs = ((const LAS float*)(lds + CS_BS))[tl];
            float o[8] = {o0[0], o0[1], o0[2], o0[3], o1[0], o1[1], o1[2], o1[3]}, vv[8];
            CS_UNPK(vw, vv);
            float sm = 0.f;
#pragma unroll
            for (int e = 0; e < 8; ++e) sm += o[e];
            const float mean = row8_sum(sm) * (1.0f / 64.0f); float q = 0.f;
#pragma unroll
            for (int e = 0; e < 8; ++e) { o[e] -= mean; q += o[e] * o[e]; }
            const float rs = 1.0f / sqrtf(row8_sum(q) * (1.0f / 64.0f) + GN_EPS);
            float z[8], lng_[8], lnb_[8];
            CS_CLD(lng_, 3); CS_CLD(lnb_, 4);
#pragma unroll
            for (int e = 0; e < 8; ++e) z[e] = (o[e] * rs * lng_[e] + lnb_[e] + vv[e] * bs) * gg[e];
            *(v4u*)(Z + (rowb + t0 + tl) * DM + col) = (v4u){cvt2(z[0], z[1]), cvt2(z[2], z[3]), cvt2(z[4], z[5]), cvt2(z[6], z[7])};
        }
    }
#undef CS_LOAD
#undef CS_CLD
#undef CS_STAGE_LD
#undef CS_STAGE_ST
#undef CS_UNPK
#undef CS_PLAIN
#undef CS_PLAINM
#undef CS_PUBMAX
#undef CS_GETMAX
#undef CS_TUPD
}
constexpr int RT_WB = 0, RT_WBP = 1040;
constexpr int RT_LG = 112640;
constexpr int RT_RI = 131072;
constexpr int RT_DE = 131584;
constexpr int RT_DG = RT_DE + 1024;
constexpr int RT_LR = RT_DG + 1024;
constexpr int RT_LC = RT_LR + 1024;
constexpr int RT_BS = RT_LC + 128;
__device__ __forceinline__ void moe_router(Frame& F, const bf16* X, const float* g, const float* wg, const float* bg, const float* we, const float* be, float* RINV, int* pairlist, float* gate, unsigned* cnt) {
    LAS unsigned char* lds = F.lds; const int tid = F.tid, lane = F.lane;
    LAS float* LG = (LAS float*)(lds + RT_LG); LAS float* RI = (LAS float*)(lds + RT_RI);
    const int rows_per = NTOK / F.G;
    const int row0 = F.vcu * rows_per + F.wave * 16;
    const int r = lane & 15, kq = lane >> 4, j = lane & 15;
    f32x4 acc0 = {0.f, 0.f, 0.f, 0.f}, acc1 = {0.f, 0.f, 0.f, 0.f}, acc2 = {0.f, 0.f, 0.f, 0.f};
    float ssq = 0.f;
    if (tid < 32) *(LAS int*)(lds + RT_LC + tid * 4) = 0;
#define RT_SPLIT_ST(col, kk_, w_) do { const float w0_ = (w_); const unsigned h_ = cvt2(w0_, 0.f) & 0xffffu; const float r1_ = w0_ - bflo(h_); const unsigned l_ = cvt2(r1_, 0.f) & 0xffffu; \
        const unsigned m_ = cvt2(r1_ - bflo(l_), 0.f) & 0xffffu; LAS unsigned char* p_ = lds + RT_WB + (col) * RT_WBP + (kk_) * 2; \
        *(LAS unsigned short*)p_ = (unsigned short)h_; *(LAS unsigned short*)(p_ + 36 * RT_WBP) = (unsigned short)l_; *(LAS unsigned short*)(p_ + 72 * RT_WBP) = (unsigned short)m_; } while (0)
    for (int half = 0; half < 2; ++half) {
        __syncthreads();
        for (int i = tid; i < 512 * 8; i += 512) { const int kk = i >> 3, c4 = (i & 7) * 4; const float gk = g[half * 512 + kk];
            const f32x4 w = *(const f32x4*)(we + (size_t)(half * 512 + kk) * 32 + c4) * gk;
            RT_SPLIT_ST(c4, kk, w[0]); RT_SPLIT_ST(c4 + 1, kk, w[1]); RT_SPLIT_ST(c4 + 2, kk, w[2]); RT_SPLIT_ST(c4 + 3, kk, w[3]); }
        { const int kk = tid; const f32x4 w = *(const f32x4*)(wg + (size_t)(half * 512 + kk) * 4) * g[half * 512 + kk];
            RT_SPLIT_ST(32, kk, w[0]); RT_SPLIT_ST(33, kk, w[1]); RT_SPLIT_ST(34, kk, w[2]); RT_SPLIT_ST(35, kk, w[3]); }
        __syncthreads();
        const bf16* xp = X + (size_t)(row0 + r) * DM + half * 512 + kq * 8;
        const LAS unsigned char* wb0 = lds + RT_WB + j * RT_WBP + kq * 16, * wb1 = wb0 + 16 * RT_WBP, * wb2 = lds + RT_WB + (32 + (j & 3)) * RT_WBP + kq * 16;
        for (int b8 = 0; b8 < 2; ++b8) {
            v4u xw[8];
#pragma unroll
            for (int i = 0; i < 8; ++i) xw[i] = *(const v4u*)(xp + (b8 * 8 + i) * 32);
#pragma unroll
            for (int i = 0; i < 8; ++i) { const int ko = (b8 * 8 + i) * 64;
#pragma unroll
                for (int e = 0; e < 4; ++e) { const float a0 = bflo(xw[i][e]), a1 = bfhi(xw[i][e]); ssq += a0 * a0 + a1 * a1; }
                const bf16x8 a = __builtin_bit_cast(bf16x8, xw[i]);
#pragma unroll
                for (int p = 0; p < 3; ++p) {
                    const bf16x8 b0 = *(const LAS bf16x8*)(wb0 + p * 36 * RT_WBP + ko), b1 = *(const LAS bf16x8*)(wb1 + p * 36 * RT_WBP + ko);
                    bf16x8 b2 = *(const LAS bf16x8*)(wb2 + p * 36 * RT_WBP + ko); if (j >= 4) b2 = (bf16x8){0, 0, 0, 0, 0, 0, 0, 0};
                    acc0 = __builtin_amdgcn_mfma_f32_16x16x32_bf16(a, b0, acc0, 0, 0, 0);
                    acc1 = __builtin_amdgcn_mfma_f32_16x16x32_bf16(a, b1, acc1, 0, 0, 0);
                    acc2 = __builtin_amdgcn_mfma_f32_16x16x32_bf16(a, b2, acc2, 0, 0, 0); }
            }
        }
    }
#undef RT_SPLIT_ST
    ssq += __shfl_xor(ssq, 16); ssq += __shfl_xor(ssq, 32);
    const float rinv = 1.0f / sqrtf(ssq * (1.0f / DM) + RMS_EPS);
    if (kq == 0) { RI[F.wave * 16 + r] = rinv; RINV[row0 + r] = rinv; }
    LDS_WAIT(); asm volatile("" ::: "memory");
    {
        const float be0 = be[j], be1 = be[16 + j], bgj = bg[j & 3];
#pragma unroll
        for (int reg = 0; reg < 4; ++reg) { const int lr = F.wave * 16 + 4 * kq + reg; const float ri = RI[lr];
            LG[lr * 36 + j] = acc0[reg] * ri + be0; LG[lr * 36 + 16 + j] = acc1[reg] * ri + be1; if (j < 4) LG[lr * 36 + 32 + j] = acc2[reg] * ri + bgj; }
    }
    __syncthreads();
    if (tid < rows_per) {
        const LAS float* lg = LG + tid * 36;
        int gi = 0; float gm = lg[32];
#pragma unroll
        for (int c = 1; c < 4; ++c) { const float v = lg[32 + c]; if (v > gm) { gm = v; gi = c; } }
        float gs = 0.f;
#pragma unroll
        for (int c = 0; c < 4; ++c) gs += __expf(lg[32 + c] - gm);
        const float pg = 1.0f / gs;
        const LAS float* el = lg + gi * 8;
        int e1 = 0; float m1 = el[0];
#pragma unroll
        for (int c = 1; c < 8; ++c) { const float v = el[c]; if (v > m1) { m1 = v; e1 = c; } }
        int e2 = e1 == 0 ? 1 : 0; float m2 = el[e2];
#pragma unroll
        for (int c = 0; c < 8; ++c) { const float v = el[c]; if (c != e1 && v > m2) { m2 = v; e2 = c; } }
        const float x2 = __expf(m2 - m1), g1 = pg / (1.0f + x2), g2 = pg * x2 / (1.0f + x2);
        const int lp = tid * 2;
        *(LAS int*)(lds + RT_DE + lp * 4) = gi * 8 + e1; *(LAS int*)(lds + RT_DE + lp * 4 + 4) = gi * 8 + e2;
        *(LAS float*)(lds + RT_DG + lp * 4) = g1; *(LAS float*)(lds + RT_DG + lp * 4 + 4) = g2;
    }
    __syncthreads();
    if (tid < 2 * rows_per) { const int e = *(LAS int*)(lds + RT_DE + tid * 4); *(LAS int*)(lds + RT_LR + tid * 4) = __hip_atomic_fetch_add((LAS int*)(lds + RT_LC) + e, 1, __ATOMIC_RELAXED, __HIP_MEMORY_SCOPE_WORKGROUP); }
    __syncthreads();
    if (tid < 32) { const int n = *(LAS int*)(lds + RT_LC + tid * 4); *(LAS int*)(lds + RT_BS + tid * 4) = n ? (int)__hip_atomic_fetch_add(cnt + 64 * tid, (unsigned)n, RLX_AGENT) : 0; }
    __syncthreads();
    if (tid < 2 * rows_per) { const int e = *(LAS int*)(lds + RT_DE + tid * 4); const int rank = *(LAS int*)(lds + RT_BS + e * 4) + *(LAS int*)(lds + RT_LR + tid * 4);
        const int pair = F.vcu * rows_per * 2 + tid;
        pairlist[(size_t)e * PLCAP + rank] = pair; gate[pair] = *(LAS float*)(lds + RT_DG + tid * 4); }
}
__device__ __forceinline__ void moe_table(Frame& F, const unsigned* cnt, LAS int* tab) {
    __syncthreads();
    if (F.tid < 32) tab[F.tid] = (int)__hip_atomic_load(cnt + 64 * F.tid, RLX_AGENT);
    __syncthreads();
    if (F.tid < 32) { const int t = F.tid, rem = tab[t] & 255; int st = 0, rank = 0, nf = 0, np = 0;
        for (int q = 0; q < 32; ++q) { const int nq = tab[q], rq = nq & 255; if (q < t) st += nq >> 8; nf += nq >> 8; np += rq ? 1 : 0;
            rank += (rq > rem || (rq == rem && q < t)) ? 1 : 0; }
        tab[32 + t] = st; tab[64 + rank] = t; if (t == 0) { tab[96] = nf; tab[97] = np; } }
    __syncthreads();
}
struct MoeCv { const float* src; int nsrc; bf16* dst; int dld, row_off, kind, n0, k0; bool scaled; };
template <int MODE>
__device__ __forceinline__ MoeCv moe_cv(int it, const float* w1, const float* w3, const float* w2, bf16* W13, bf16* W2T) {
    MoeCv m; const int e = MODE == 0 ? it / 512 : it / 256, mat = MODE == 0 ? (it >> 8) & 1 : 2, li = it & 255;
    if (mat < 2) { const int kb = li >> 4, nb = li & 15; m.k0 = 64 * kb; m.n0 = 32 * nb; m.nsrc = FF; m.src = (mat == 0 ? w1 : w3) + (size_t)e * DM * FF + (size_t)m.k0 * FF + m.n0;
        m.dst = W13 + (size_t)e * 1024 * DM; m.dld = DM; m.row_off = mat * 128; m.kind = 3; m.scaled = true; }
    else { const int kb = li >> 5, nb = li & 31; m.k0 = 64 * kb; m.n0 = 32 * nb; m.nsrc = DM; m.src = w2 + (size_t)e * FF * DM + (size_t)m.k0 * DM + m.n0;
        m.dst = W2T + (size_t)e * DM * FF; m.dld = FF; m.row_off = 0; m.kind = 1; m.scaled = false; }
    return m;
}
template <int MODE>
__device__ __forceinline__ void moe_convert(Frame& F, int gw, int NGW, const float* w1, const float* w3, const float* w2, const float* gffn, bf16* W13, bf16* W2T) {
    LAS float* scr = (LAS float*)(F.lds + F.wave * 16384);
    const int lane = F.lane, rr = lane >> 3, c4 = (lane & 7) * 4;
    constexpr int NITEM = MODE == 0 ? NEXP * 512 : NEXP * 256;
    if (gw >= NITEM) return;
    f32x4 wa[8], wb[8]; MoeCv ma, mb;
#define CV_LOAD(W, M, it_) do { M = moe_cv<MODE>((it_), w1, w3, w2, W13, W2T); \
        _Pragma("unroll") for (int i = 0; i < 8; ++i) W[i] = *(const f32x4*)(M.src + (size_t)(8 * i + rr) * M.nsrc + c4); } while (0)
#define CV_PROC(W, M, nxt_) do { const MoeCv m = M; \
        _Pragma("unroll") for (int i = 0; i < 8; ++i) { const int kk = 8 * i + rr; f32x4 v = W[i]; if (m.scaled) v = v * gffn[m.k0 + kk]; \
            scr[kk * 33 + c4] = v[0]; scr[kk * 33 + c4 + 1] = v[1]; scr[kk * 33 + c4 + 2] = v[2]; scr[kk * 33 + c4 + 3] = v[3]; } \
        if ((nxt_) < NITEM) CV_LOAD(W, M, (nxt_));                       \
        LDS_WAIT(); asm volatile("" ::: "memory"); \
        const int c = lane & 7; \
        _Pragma("unroll") for (int j = 0; j < 4; ++j) { const int n = (lane >> 3) + 8 * j; const LAS float* sp = scr + (8 * c) * 33 + n; \
            v4u o; o.x = cvt2(sp[0 * 33], sp[1 * 33]); o.y = cvt2(sp[2 * 33], sp[3 * 33]); o.z = cvt2(sp[4 * 33], sp[5 * 33]); o.w = cvt2(sp[6 * 33], sp[7 * 33]); \
            *(v4u*)(m.dst + (size_t)(m.row_off + rowmap(m.kind, m.n0 + n)) * m.dld + m.k0 + 8 * c) = o; } \
        LDS_WAIT(); asm volatile("" ::: "memory"); } while (0)
    CV_LOAD(wa, ma, gw);
    if (gw + NGW < NITEM) CV_LOAD(wb, mb, gw + NGW);
    for (int it = gw; it < NITEM; it += 2 * NGW) {
        CV_PROC(wa, ma, it + 2 * NGW);
        if (it + NGW < NITEM) CV_PROC(wb, mb, it + 3 * NGW);
    }
#undef CV_LOAD
#undef CV_PROC
}
__device__ __forceinline__ void moba_kmean(Frame& F, const bf16* K, int b, int h) {
    LAS unsigned char* lds = F.lds; const int tid = F.tid;
    LAS float* part = (LAS float*)lds;
    LAS float* km = (LAS float*)(lds + attn_body::LDS_KMEAN);
    const int c8 = tid & 7, rg = tid >> 3;
    for (int blk = 0; blk < 7; ++blk) {
        float s[8] = {0.f, 0.f, 0.f, 0.f, 0.f, 0.f, 0.f, 0.f};
#pragma unroll
        for (int rr = 0; rr < 4; ++rr) { const int row = blk * 256 + rg + 64 * rr; const v4u w = *(const v4u*)(K + ((size_t)b * SEQ + row) * DM + h * HD + 8 * c8);
            s[0] += bflo(w.x); s[1] += bfhi(w.x); s[2] += bflo(w.y); s[3] += bfhi(w.y); s[4] += bflo(w.z); s[5] += bfhi(w.z); s[6] += bflo(w.w); s[7] += bfhi(w.w); }
        *(LAS f32x4*)(part + rg * 64 + 8 * c8) = (f32x4){s[0], s[1], s[2], s[3]}; *(LAS f32x4*)(part + rg * 64 + 8 * c8 + 4) = (f32x4){s[4], s[5], s[6], s[7]};
        __syncthreads();
        if (tid < 64) { float t = 0.f; for (int q = 0; q < 64; ++q) t += part[q * 64 + tid]; km[blk * 64 + tid] = t * (1.0f / 256.0f); }
        __syncthreads();
    }
}

__device__ __forceinline__ pg8::GemmCfg mkcfg(int lda, int ldb, int K) { pg8::GemmCfg g; g.lda = lda; g.ldb = ldb; g.K = K; g.kj_tile = 1 << 30; g.kj_bytes = 0; return g; }
__device__ __forceinline__ BatchSched mkbs(int G, int c, int nb, int nM, int nN, int lda, int ldb, const void* A, const void* B, size_t strideA, size_t strideB) {
    BatchSched S; S.G = G; S.c = c; S.nb = nb; S.nM = nM; S.nN = nN; S.lda = lda; S.ldb = ldb; S.A = (const char*)A; S.B = (const char*)B; S.strideA = strideA; S.strideB = strideB; S.plain = false; return S; }
__device__ __forceinline__ EpiStore mkes(bf16* O, int ldo, size_t strideO, bool nat) { EpiStore E; E.O = O; E.ldo = ldo; E.strideO = strideO; E.nat = nat; return E; }

constexpr int N_PHASES = 20;
__global__ void __launch_bounds__(NWAVES * 64, 2) mega_fwd(Args args) {
    extern __shared__ __attribute__((aligned(16))) unsigned char lds_raw[];
    Frame F;
    F.lds = (LAS unsigned char*)lds_raw;
    F.tid = threadIdx.x; F.lane = F.tid & 63; F.wave = __builtin_amdgcn_readfirstlane(F.tid >> 6);
    F.G = gridDim.x; { const int bx = blockIdx.x; F.vcu = (F.G % 8 == 0) ? (bx % 8) * (F.G / 8) + bx / 8 : bx; }
    F.ws = args.ws;
    unsigned char* ws = args.ws;
    volatile LAS unsigned* MISC = (volatile LAS unsigned*)(F.lds + MISC_OFF);
    for (int u = F.tid; u < 128; u += NWAVES * 64) MISC[u] = 0u;
    __syncthreads();
    unsigned* ctl = (unsigned*)(ws + WS_CTL);
    XcdBarrier bar = xcd_barrier_post(ctl + CW_BAR, MISC + 8);
    const int lo = args.ph_lo, hi = args.ph_hi;
#ifndef PH_SEL
#define PH_SEL(k) true
#endif
#define IN(k) (PH_SEL(k) && lo <= (k) && (k) < hi)
#define SEAM(k) do { if (IN(k) && IN((k) + 1)) xcd_barrier(bar); } while (0)
    LAS unsigned char* ring = F.lds + RING_OFF;
    const int cblk = (int)blockIdx.x;


    if (IN(0)) p0_prologue(F, args);
    SEAM(0);
    if (IN(1)) {
        {
            const BatchSched S = mkbs(F.G, cblk, 3, NTOK / 256, 4, DM, DM, ws + ARENA(0), ws + WS_WRKV, UNIT, (size_t)DM * DM * 2);
            pg8::gemm_phase(ring, mkcfg(DM, DM, DM), S, mkes((bf16*)(ws + ARENA(3)), DM, UNIT / 2, false)); }
        {
            const BatchSched S = mkbs(F.G, (cblk + 128) & 255, 2, NMEM / 256, 4, DM, DM, ws + WS_MEMN, ws + WS_WMXK, (size_t)NMEM * DM * 2, (size_t)DM * DM * 2);
            pg8::gemm_phase(ring, mkcfg(DM, DM, DM), S, mkes((bf16*)(ws + WS_KMEM), DM, (size_t)NMEM * DM, false)); }
        {
            const BatchSched S = mkbs(F.G, (cblk + 128) & 255, 2, NMEM / 256, 4, DM, DM, ws + WS_MEMN, ws + WS_WMXV, (size_t)NMEM * DM * 2, (size_t)DM * DM * 2);
            pg8::gemm_phase(ring, mkcfg(DM, DM, DM), S, mkes((bf16*)(ws + WS_VMEM), DM, (size_t)NMEM * DM, false)); }
        LoraDownSched S2; S2.G = F.G; S2.c = cblk; S2.hp = (const char*)(ws + ARENA(6)); S2.B = (const char*)(ws + WS_WLD);
        pg8::GemmCfg g2 = mkcfg(DM, 2048, 2048); g2.kj_tile = 16; g2.kj_bytes = 4096;
        EpiLoraDown E2; E2.O = (bf16*)(ws + WS_LO);
        pg8::gemm_phase(ring, g2, S2, E2);
    }
    SEAM(1);
#ifndef SCAN_SEQ
    if (IN(3)) rwkv_scan_chunked(F, (const bf16*)(ws + ARENA(3)), (const bf16*)(ws + ARENA(4)), (const bf16*)(ws + ARENA(5)), (const bf16*)(ws + WS_LO), (const bf16*)(ws + WS_WLU), (const float*)INP(8), (const float*)INP(11), (bf16*)(ws + ARENA(6)));
#else
    if (IN(3)) rwkv_scan(F, args, (const bf16*)(ws + ARENA(3)), (const bf16*)(ws + ARENA(4)), (const bf16*)(ws + ARENA(5)), (const bf16*)(ws + ARENA(0)), (const bf16*)(ws + ARENA(1)), (const bf16*)(ws + ARENA(2)), (bf16*)(ws + ARENA(6)));
#endif
    SEAM(3);

    {
        constexpr int l = 0; constexpr int pb = 4;
        constexpr int A_MIX = l == 0 ? 6 : 1, A_TAB = 3, A_P = 2, A_W13 = 4, A_W2T = 5, A_HB = 1, A_YB = 2;
        bf16* X = (bf16*)(ws + ARENA(0));
        if (l == 1) {
            if (IN(11)) {
                const BatchSched S = mkbs(F.G, cblk, 1, NTOK / 256, 12, DM, DM, ws + ARENA(0), ws + WS_WMBQKV, 0, 0);
                EpiQKVRope E; E.Q = (bf16*)(ws + ARENA(4)); E.K = (bf16*)(ws + ARENA(5)); E.V = (bf16*)(ws + ARENA(6)); E.rope = (const f32x2*)(ws + WS_ROPE); E.rinv = (const float*)(ws + WS_RINV);
                pg8::gemm_phase(ring, mkcfg(DM, DM, DM), S, E);
            }
            SEAM(11);
            if (IN(12)) {
                const int bh = F.vcu;
                if (bh < BATCH * NHEAD) {
                    const int b = bh / NHEAD, h = bh % NHEAD;
                    moba_kmean(F, (const bf16*)(ws + ARENA(5)), b, h);
                    for (int qb = 7; qb >= 0; --qb)
                        attn_body::attn_unit<8>(b, h, qb, (const attn_body::bf16*)(ws + ARENA(4)), (const attn_body::bf16*)(ws + ARENA(5)), (const attn_body::bf16*)(ws + ARENA(6)), (attn_body::bf16*)(ws + ARENA(1)), (char*)lds_raw);
                }
            }
            SEAM(12);
        }
        if (IN(pb)) {
            { const BatchSched S = mkbs(F.G, cblk, 1, NTOK / 256, 4, DM, DM, ws + ARENA(A_MIX), ws + (l == 0 ? WS_WRWO : WS_WMBO), 0, 0);
              EpiResidual<true, l == 0> E; E.src = l == 0 ? INP(0) : (const void*)X; E.X = X; E.jobrows = 0; E.SSQ = (float*)(ws + WS_SSQ); E.xch = (LAS float*)(F.lds + EPI_OFF);
              pg8::gemm_phase(ring, mkcfg(DM, DM, DM), S, E); }
            if (l == 0) {
            { XAttnSched S; S.G = F.G; S.c = F.vcu; S.mode = 0; S.A = (const char*)(ws + WS_KMEM) + (size_t)l * NMEM * DM * 2; S.B = (const char*)(ws + WS_WMXQ) + (size_t)l * DM * DM * 2;
              pg8::gemm_phase(ring, mkcfg(DM, DM, 256), S, mkes((bf16*)(ws + ARENA(A_TAB)), DM, (size_t)MEMT * DM, true)); }
            { XAttnSched S; S.G = F.G; S.c = F.vcu; S.mode = 1; S.A = (const char*)(ws + WS_WMXO) + (size_t)l * DM * DM * 2; S.B = (const char*)(ws + WS_VMEM) + (size_t)l * NMEM * DM * 2;
              pg8::gemm_phase(ring, mkcfg(DM, DM, 256), S, mkes((bf16*)(ws + ARENA(A_TAB)) + (size_t)32 * MiB / 2, DM, (size_t)DM * DM, true)); }
            }
        }
        SEAM(pb);
        if (IN(pb + 1)) {
            XAttnSched S; S.G = F.G; S.c = F.vcu; S.mode = 2; S.A = (const char*)X; S.B = (const char*)(ws + ARENA(A_TAB));
            EpiSoftmax E; E.P = (bf16*)(ws + ARENA(A_P)); E.xch = (LAS float*)(F.lds + EPI_OFF); E.SSQ = (const float*)(ws + WS_SSQ);
            pg8::gemm_phase(ring, mkcfg(DM, DM, DM), S, E);
        }
        SEAM(pb + 1);
        if (IN(pb + 2)) {
            BatchSched S = mkbs(F.G, F.vcu, BATCH, SEQ / 256, 4, DM, DM, ws + ARENA(A_P), ws + ARENA(A_TAB) + 32 * MiB, (size_t)SEQ * DM * 2, (size_t)DM * DM * 2); S.plain = true;
            EpiResidual<false, false> E; E.src = X; E.X = X; E.jobrows = SEQ; E.SSQ = nullptr; E.xch = (LAS float*)(F.lds + EPI_OFF);
            pg8::gemm_phase(ring, mkcfg(DM, DM, DM), S, E);
        }
        SEAM(pb + 2);
        unsigned* cnt = ctl + CW_CNT + l * 32 * 64;
        int* pairlist = (int*)(ws + WS_PAIRLIST); float* gate = (float*)(ws + WS_GATE);
        if (IN(pb + 3)) {
            if (F.vcu & 1) { moe_convert<0>(F, F.vcu * NWAVES + F.wave, F.G * NWAVES, (const float*)INP(32) + (size_t)l * NEXP * DM * FF, (const float*)INP(33) + (size_t)l * NEXP * DM * FF, (const float*)INP(34) + (size_t)l * NEXP * FF * DM, (const float*)INP(6) + l * DM, (bf16*)(ws + ARENA(A_W13)), (bf16*)(ws + ARENA(A_W2T)));
                __syncthreads();
                moe_router(F, X, (const float*)INP(6) + l * DM, (const float*)INP(28) + (size_t)l * DM * 4, (const float*)INP(29) + l * 4, (const float*)INP(30) + (size_t)l * DM * 32, (const float*)INP(31) + l * 32,
                               (float*)(ws + WS_RINV), pairlist, gate, cnt); }
            else { moe_router(F, X, (const float*)INP(6) + l * DM, (const float*)INP(28) + (size_t)l * DM * 4, (const float*)INP(29) + l * 4, (const float*)INP(30) + (size_t)l * DM * 32, (const float*)INP(31) + l * 32,
                               (float*)(ws + WS_RINV), pairlist, gate, cnt);
                __syncthreads();
                moe_convert<0>(F, F.vcu * NWAVES + F.wave, F.G * NWAVES, (const float*)INP(32) + (size_t)l * NEXP * DM * FF, (const float*)INP(33) + (size_t)l * NEXP * DM * FF, (const float*)INP(34) + (size_t)l * NEXP * FF * DM, (const float*)INP(6) + l * DM, (bf16*)(ws + ARENA(A_W13)), (bf16*)(ws + ARENA(A_W2T))); }
        }
        SEAM(pb + 3);
        if (IN(pb + 4)) {
            MoeSched S; S.G = F.G; S.c = F.vcu; S.shift = 1; S.ncol = 4; S.cstep = 128; S.A = (const char*)X; S.B = (const char*)(ws + ARENA(A_W13)); S.bstride_e = (size_t)1024 * DM * 2; S.bstride_n = (size_t)256 * DM * 2; S.pairlist = pairlist; S.tab = (LAS int*)(F.lds + EPI_OFF + 8192); moe_table(F, cnt, (LAS int*)(F.lds + EPI_OFF + 8192));
            EpiMoE1 E; E.H = (bf16*)(ws + ARENA(A_HB)); E.pairlist = pairlist; E.rinv = (const float*)(ws + WS_RINV);
            pg8::gemm_phase(ring, mkcfg(DM, DM, DM), S, E);
            {
                const int nun = 4 * (S.tab[96] + S.tab[97]), rem = nun % F.G;
                if (rem == 0 || F.vcu >= rem)
                    moe_convert<1>(F, (rem ? F.vcu - rem : F.vcu) * NWAVES + F.wave, (rem ? F.G - rem : F.G) * NWAVES, (const float*)INP(32) + (size_t)l * NEXP * DM * FF, (const float*)INP(33) + (size_t)l * NEXP * DM * FF, (const float*)INP(34) + (size_t)l * NEXP * FF * DM, (const float*)INP(6) + l * DM, (bf16*)(ws + ARENA(A_W13)), (bf16*)(ws + ARENA(A_W2T)));
            }
        }
        SEAM(pb + 4);
        if (IN(pb + 5)) {
            MoeSched S; S.G = F.G; S.c = cblk; S.shift = 0; S.ncol = 4; S.cstep = 256; S.A = (const char*)(ws + ARENA(A_HB)); S.B = (const char*)(ws + ARENA(A_W2T)); S.bstride_e = (size_t)DM * FF * 2; S.bstride_n = (size_t)256 * FF * 2; S.pairlist = pairlist; S.tab = (LAS int*)(F.lds + EPI_OFF + 8192); moe_table(F, cnt, (LAS int*)(F.lds + EPI_OFF + 8192));
            EpiMoE2 E; E.Y = (unsigned char*)(ws + ARENA(A_YB)); E.pairlist = pairlist; E.gate = gate;
            pg8::gemm_phase(ring, mkcfg(FF, FF, FF), S, E);
        }
        SEAM(pb + 5);
        if (IN(pb + 6)) {
            if (l == 0 && (F.vcu & 1)) {
                { XAttnSched S; S.G = F.G; S.c = F.vcu; S.mode = 0; S.A = (const char*)(ws + WS_KMEM) + (size_t)1 * NMEM * DM * 2; S.B = (const char*)(ws + WS_WMXQ) + (size_t)1 * DM * DM * 2;
                  pg8::gemm_phase(ring, mkcfg(DM, DM, 256), S, mkes((bf16*)(ws + ARENA(A_TAB)), DM, (size_t)MEMT * DM, true)); }
                { XAttnSched S; S.G = F.G; S.c = F.vcu; S.mode = 1; S.A = (const char*)(ws + WS_WMXO) + (size_t)1 * DM * DM * 2; S.B = (const char*)(ws + WS_VMEM) + (size_t)1 * NMEM * DM * 2;
                  pg8::gemm_phase(ring, mkcfg(DM, DM, 256), S, mkes((bf16*)(ws + ARENA(A_TAB)) + (size_t)32 * MiB / 2, DM, (size_t)DM * DM, true)); }
            }
            combine_rows(F, X, (const unsigned char*)(ws + ARENA(A_YB)), l == 0 ? (const float*)INP(3) + DM : (const float*)INP(35), (float*)(ws + WS_RINV), args.out, l == 1);
            if (l == 0 && !(F.vcu & 1)) {
                { XAttnSched S; S.G = F.G; S.c = F.vcu; S.mode = 0; S.A = (const char*)(ws + WS_KMEM) + (size_t)1 * NMEM * DM * 2; S.B = (const char*)(ws + WS_WMXQ) + (size_t)1 * DM * DM * 2;
                  pg8::gemm_phase(ring, mkcfg(DM, DM, 256), S, mkes((bf16*)(ws + ARENA(A_TAB)), DM, (size_t)MEMT * DM, true)); }
                { XAttnSched S; S.G = F.G; S.c = F.vcu; S.mode = 1; S.A = (const char*)(ws + WS_WMXO) + (size_t)1 * DM * DM * 2; S.B = (const char*)(ws + WS_VMEM) + (size_t)1 * NMEM * DM * 2;
                  pg8::gemm_phase(ring, mkcfg(DM, DM, 256), S, mkes((bf16*)(ws + ARENA(A_TAB)) + (size_t)32 * MiB / 2, DM, (size_t)DM * DM, true)); }
            }
        }
        if (l == 0) SEAM(pb + 6);
    }
    {
        constexpr int l = 1; constexpr int pb = 13;
        constexpr int A_MIX = l == 0 ? 6 : 1, A_TAB = 3, A_P = 2, A_W13 = 4, A_W2T = 5, A_HB = 1, A_YB = 2;
        bf16* X = (bf16*)(ws + ARENA(0));
        if (l == 1) {
            if (IN(11)) {
                const BatchSched S = mkbs(F.G, cblk, 1, NTOK / 256, 12, DM, DM, ws + ARENA(0), ws + WS_WMBQKV, 0, 0);
                EpiQKVRope E; E.Q = (bf16*)(ws + ARENA(4)); E.K = (bf16*)(ws + ARENA(5)); E.V = (bf16*)(ws + ARENA(6)); E.rope = (const f32x2*)(ws + WS_ROPE); E.rinv = (const float*)(ws + WS_RINV);
                pg8::gemm_phase(ring, mkcfg(DM, DM, DM), S, E);
            }
            SEAM(11);
            if (IN(12)) {
                const int bh = F.vcu;
                if (bh < BATCH * NHEAD) {
                    const int b = bh / NHEAD, h = bh % NHEAD;
                    moba_kmean(F, (const bf16*)(ws + ARENA(5)), b, h);
                    for (int qb = 7; qb >= 0; --qb)
                        attn_body::attn_unit<8>(b, h, qb, (const attn_body::bf16*)(ws + ARENA(4)), (const attn_body::bf16*)(ws + ARENA(5)), (const attn_body::bf16*)(ws + ARENA(6)), (attn_body::bf16*)(ws + ARENA(1)), (char*)lds_raw);
                }
            }
            SEAM(12);
        }
        if (IN(pb)) {
            { const BatchSched S = mkbs(F.G, cblk, 1, NTOK / 256, 4, DM, DM, ws + ARENA(A_MIX), ws + (l == 0 ? WS_WRWO : WS_WMBO), 0, 0);
              EpiResidual<true, l == 0> E; E.src = l == 0 ? INP(0) : (const void*)X; E.X = X; E.jobrows = 0; E.SSQ = (float*)(ws + WS_SSQ); E.xch = (LAS float*)(F.lds + EPI_OFF);
              pg8::gemm_phase(ring, mkcfg(DM, DM, DM), S, E); }
            if (l == 0) {
            { XAttnSched S; S.G = F.G; S.c = F.vcu; S.mode = 0; S.A = (const char*)(ws + WS_KMEM) + (size_t)l * NMEM * DM * 2; S.B = (const char*)(ws + WS_WMXQ) + (size_t)l * DM * DM * 2;
              pg8::gemm_phase(ring, mkcfg(DM, DM, 256), S, mkes((bf16*)(ws + ARENA(A_TAB)), DM, (size_t)MEMT * DM, true)); }
            { XAttnSched S; S.G = F.G; S.c = F.vcu; S.mode = 1; S.A = (const char*)(ws + WS_WMXO) + (size_t)l * DM * DM * 2; S.B = (const char*)(ws + WS_VMEM) + (size_t)l * NMEM * DM * 2;
              pg8::gemm_phase(ring, mkcfg(DM, DM, 256), S, mkes((bf16*)(ws + ARENA(A_TAB)) + (size_t)32 * MiB / 2, DM, (size_t)DM * DM, true)); }
            }
        }
        SEAM(pb);
        if (IN(pb + 1)) {
            XAttnSched S; S.G = F.G; S.c = F.vcu; S.mode = 2; S.A = (const char*)X; S.B = (const char*)(ws + ARENA(A_TAB));
            EpiSoftmax E; E.P = (bf16*)(ws + ARENA(A_P)); E.xch = (LAS float*)(F.lds + EPI_OFF); E.SSQ = (const float*)(ws + WS_SSQ);
            pg8::gemm_phase(ring, mkcfg(DM, DM, DM), S, E);
        }
        SEAM(pb + 1);
        if (IN(pb + 2)) {
            BatchSched S = mkbs(F.G, F.vcu, BATCH, SEQ / 256, 4, DM, DM, ws + ARENA(A_P), ws + ARENA(A_TAB) + 32 * MiB, (size_t)SEQ * DM * 2, (size_t)DM * DM * 2); S.plain = true;
            EpiResidual<false, false> E; E.src = X; E.X = X; E.jobrows = SEQ; E.SSQ = nullptr; E.xch = (LAS float*)(F.lds + EPI_OFF);
            pg8::gemm_phase(ring, mkcfg(DM, DM, DM), S, E);
        }
        SEAM(pb + 2);
        unsigned* cnt = ctl + CW_CNT + l * 32 * 64;
        int* pairlist = (int*)(ws + WS_PAIRLIST); float* gate = (float*)(ws + WS_GATE);
        if (IN(pb + 3)) {
            if (F.vcu & 1) { moe_convert<0>(F, F.vcu * NWAVES + F.wave, F.G * NWAVES, (const float*)INP(32) + (size_t)l * NEXP * DM * FF, (const float*)INP(33) + (size_t)l * NEXP * DM * FF, (const float*)INP(34) + (size_t)l * NEXP * FF * DM, (const float*)INP(6) + l * DM, (bf16*)(ws + ARENA(A_W13)), (bf16*)(ws + ARENA(A_W2T)));
                __syncthreads();
                moe_router(F, X, (const float*)INP(6) + l * DM, (const float*)INP(28) + (size_t)l * DM * 4, (const float*)INP(29) + l * 4, (const float*)INP(30) + (size_t)l * DM * 32, (const float*)INP(31) + l * 32,
                               (float*)(ws + WS_RINV), pairlist, gate, cnt); }
            else { moe_router(F, X, (const float*)INP(6) + l * DM, (const float*)INP(28) + (size_t)l * DM * 4, (const float*)INP(29) + l * 4, (const float*)INP(30) + (size_t)l * DM * 32, (const float*)INP(31) + l * 32,
                               (float*)(ws + WS_RINV), pairlist, gate, cnt);
                __syncthreads();
                moe_convert<0>(F, F.vcu * NWAVES + F.wave, F.G * NWAVES, (const float*)INP(32) + (size_t)l * NEXP * DM * FF, (const float*)INP(33) + (size_t)l * NEXP * DM * FF, (const float*)INP(34) + (size_t)l * NEXP * FF * DM, (const float*)INP(6) + l * DM, (bf16*)(ws + ARENA(A_W13)), (bf16*)(ws + ARENA(A_W2T))); }
        }
        SEAM(pb + 3);
        if (IN(pb + 4)) {
            MoeSched S; S.G = F.G; S.c = F.vcu; S.shift = 1; S.ncol = 4; S.cstep = 128; S.A = (const char*)X; S.B = (const char*)(ws + ARENA(A_W13)); S.bstride_e = (size_t)1024 * DM * 2; S.bstride_n = (size_t)256 * DM * 2; S.pairlist = pairlist; S.tab = (LAS int*)(F.lds + EPI_OFF + 8192); moe_table(F, cnt, (LAS int*)(F.lds + EPI_OFF + 8192));
            EpiMoE1 E; E.H = (bf16*)(ws + ARENA(A_HB)); E.pairlist = pairlist; E.rinv = (const float*)(ws + WS_RINV);
            pg8::gemm_phase(ring, mkcfg(DM, DM, DM), S, E);
            {
                const int nun = 4 * (S.tab[96] + S.tab[97]), rem = nun % F.G;
                if (rem == 0 || F.vcu >= rem)
                    moe_convert<1>(F, (rem ? F.vcu - rem : F.vcu) * NWAVES + F.wave, (rem ? F.G - rem : F.G) * NWAVES, (const float*)INP(32) + (size_t)l * NEXP * DM * FF, (const float*)INP(33) + (size_t)l * NEXP * DM * FF, (const float*)INP(34) + (size_t)l * NEXP * FF * DM, (const float*)INP(6) + l * DM, (bf16*)(ws + ARENA(A_W13)), (bf16*)(ws + ARENA(A_W2T)));
            }
        }
        SEAM(pb + 4);
        if (IN(pb + 5)) {
            MoeSched S; S.G = F.G; S.c = cblk; S.shift = 0; S.ncol = 4; S.cstep = 256; S.A = (const char*)(ws + ARENA(A_HB)); S.B = (const char*)(ws + ARENA(A_W2T)); S.bstride_e = (size_t)DM * FF * 2; S.bstride_n = (size_t)256 * FF * 2; S.pairlist = pairlist; S.tab = (LAS int*)(F.lds + EPI_OFF + 8192); moe_table(F, cnt, (LAS int*)(F.lds + EPI_OFF + 8192));
            EpiMoE2 E; E.Y = (unsigned char*)(ws + ARENA(A_YB)); E.pairlist = pairlist; E.gate = gate;
            pg8::gemm_phase(ring, mkcfg(FF, FF, FF), S, E);
        }
        SEAM(pb + 5);
        if (IN(pb + 6)) {
            if (l == 0 && (F.vcu & 1)) {
                { XAttnSched S; S.G = F.G; S.c = F.vcu; S.mode = 0; S.A = (const char*)(ws + WS_KMEM) + (size_t)1 * NMEM * DM * 2; S.B = (const char*)(ws + WS_WMXQ) + (size_t)1 * DM * DM * 2;
                  pg8::gemm_phase(ring, mkcfg(DM, DM, 256), S, mkes((bf16*)(ws + ARENA(A_TAB)), DM, (size_t)MEMT * DM, true)); }
                { XAttnSched S; S.G = F.G; S.c = F.vcu; S.mode = 1; S.A = (const char*)(ws + WS_WMXO) + (size_t)1 * DM * DM * 2; S.B = (const char*)(ws + WS_VMEM) + (size_t)1 * NMEM * DM * 2;
                  pg8::gemm_phase(ring, mkcfg(DM, DM, 256), S, mkes((bf16*)(ws + ARENA(A_TAB)) + (size_t)32 * MiB / 2, DM, (size_t)DM * DM, true)); }
            }
            combine_rows(F, X, (const unsigned char*)(ws + ARENA(A_YB)), l == 0 ? (const float*)INP(3) + DM : (const float*)INP(35), (float*)(ws + WS_RINV), args.out, l == 1);
            if (l == 0 && !(F.vcu & 1)) {
                { XAttnSched S; S.G = F.G; S.c = F.vcu; S.mode = 0; S.A = (const char*)(ws + WS_KMEM) + (size_t)1 * NMEM * DM * 2; S.B = (const char*)(ws + WS_WMXQ) + (size_t)1 * DM * DM * 2;
                  pg8::gemm_phase(ring, mkcfg(DM, DM, 256), S, mkes((bf16*)(ws + ARENA(A_TAB)), DM, (size_t)MEMT * DM, true)); }
                { XAttnSched S; S.G = F.G; S.c = F.vcu; S.mode = 1; S.A = (const char*)(ws + WS_WMXO) + (size_t)1 * DM * DM * 2; S.B = (const char*)(ws + WS_VMEM) + (size_t)1 * NMEM * DM * 2;
                  pg8::gemm_phase(ring, mkcfg(DM, DM, 256), S, mkes((bf16*)(ws + ARENA(A_TAB)) + (size_t)32 * MiB / 2, DM, (size_t)DM * DM, true)); }
            }
        }
        if (l == 0) SEAM(pb + 6);
    }
#undef IN
#undef SEAM
}

extern "C" void kernel_launch(void* const* d_in, const int* in_sizes, int n_in, void* d_out, int out_size, void* d_ws, size_t ws_size, hipStream_t stream) {
    static int grid = 0;
    if (grid == 0) {
        if (n_in != 36 || in_sizes[0] != NTOK * DM || out_size != NTOK * DM || ws_size < WS_END) { fprintf(stderr, "kernel_launch: unexpected problem (n_in %d, in0 %d, out %d, ws %zu < %zu); nothing launched\n", n_in, n_in > 0 ? in_sizes[0] : -1, out_size, ws_size, (size_t)WS_END); grid = -1; return; }
        int dev = 0, cus = 0, per_cu = 0;
        if (hipGetDevice(&dev) != hipSuccess || hipDeviceGetAttribute(&cus, hipDeviceAttributeMultiprocessorCount, dev) != hipSuccess) { grid = -1; return; }
        if (hipFuncSetAttribute((const void*)mega_fwd, hipFuncAttributeMaxDynamicSharedMemorySize, LDS_BYTES) != hipSuccess) { fprintf(stderr, "kernel_launch: hipFuncSetAttribute failed\n"); grid = -1; return; }
        if (hipOccupancyMaxActiveBlocksPerMultiprocessor(&per_cu, (const void*)mega_fwd, NWAVES * 64, LDS_BYTES) != hipSuccess || per_cu < 1) fprintf(stderr, "kernel_launch: occupancy query reports %d\n", per_cu);
        (void)hipGetLastError();
        grid = cus;
        if (grid != 256) { fprintf(stderr, "kernel_launch: built for 256 CUs, device has %d; nothing launched\n", grid); grid = -1; return; }
    }
    if (grid < 0) return;
    if (hipMemsetAsync((char*)d_ws + WS_CTL, 0, CTL_ZERO_BYTES, stream) != hipSuccess) return;
    Args a{};
    for (int i = 0; i < 36; ++i) a.in[i] = d_in[i];
    a.out = (float*)d_out; a.ws = (unsigned char*)d_ws; a.ph_lo = 0; a.ph_hi = N_PHASES;
#if defined(REP_LO) && defined(REP_HI)
    a.ph_hi = REP_HI;
    hipLaunchKernelGGL(mega_fwd, dim3(grid), dim3(NWAVES * 64), LDS_BYTES, stream, a);
#ifdef REP_ZERO_ALL
    (void)hipMemsetAsync((char*)d_ws + WS_CTL, 0, CTL_ZERO_BYTES, stream);
#else
    (void)hipMemsetAsync((char*)d_ws + WS_CTL + (size_t)CW_BAR * 4, 0, (size_t)XCD_BAR_WORDS * 4, stream);
#endif
    a.ph_lo = REP_LO; a.ph_hi = N_PHASES;
#endif
    hipLaunchKernelGGL(mega_fwd, dim3(grid), dim3(NWAVES * 64), LDS_BYTES, stream, a);
}
```

```cpp
#include <hip/hip_runtime.h>
#include <hip/hip_bf16.h>
#include <cstdio>
#include <cstdint>
#include <cmath>

#define GAS __attribute__((address_space(1)))
#define LAS __attribute__((address_space(3)))
typedef unsigned short bf16;
typedef unsigned v4u __attribute__((ext_vector_type(4)));
typedef unsigned v2u __attribute__((ext_vector_type(2)));
typedef float f32x4 __attribute__((ext_vector_type(4)));
typedef float f32x2 __attribute__((ext_vector_type(2)));
typedef short bf16x8 __attribute__((ext_vector_type(8)));
typedef GAS unsigned gu32;
#define RLX_AGENT __ATOMIC_RELAXED, __HIP_MEMORY_SCOPE_AGENT
#define LDS_WAIT() asm volatile("s_waitcnt lgkmcnt(0)" ::: "memory")
#define VM_WAIT() asm volatile("s_waitcnt vmcnt(0)" ::: "memory")

constexpr int BATCH = 16, SEQ = 2048, DM = 1024, NTOK = BATCH * SEQ, NHEAD = 16, HD = 64;
constexpr int MEMT = 256, MEMH = 4, NMEM = BATCH * MEMT;
constexpr int NEXP = 32, FF = 512, NPAIR = NTOK * 2, PLCAP = 32768;
constexpr float RMS_EPS = 1e-6f, GN_EPS = 64e-5f;
constexpr int NWAVES = 8;

constexpr size_t MiB = 1u << 20;
constexpr size_t WS_CTL = 0, CTL_ZERO_BYTES = 64 * 1024;
constexpr size_t WS_WRKV = 2 * MiB;
constexpr size_t WS_WRWO = 8 * MiB;
constexpr size_t WS_WLD = 10 * MiB;
constexpr size_t WS_WLU = 11 * MiB;
constexpr size_t WS_WMBQKV = 13 * MiB;
constexpr size_t WS_WMBO = 19 * MiB;
constexpr size_t WS_WMXQ = 21 * MiB;
constexpr size_t WS_WMXK = 25 * MiB;
constexpr size_t WS_WMXV = 29 * MiB;
constexpr size_t WS_WMXO = 33 * MiB;
constexpr size_t WS_ROPE = 37 * MiB;
constexpr size_t WS_MEMN = 45 * MiB;
constexpr size_t WS_KMEM = 61 * MiB;
constexpr size_t WS_VMEM = 77 * MiB;
constexpr size_t WS_RINV = 97 * MiB + 256 * 1024;
constexpr size_t WS_SSQ = 97 * MiB + 512 * 1024;
constexpr size_t WS_PAIRLIST = 93 * MiB;
constexpr size_t WS_GATE = 97 * MiB;
constexpr size_t WS_LO = 98 * MiB;
constexpr size_t WS_ARENA = 114 * MiB;
constexpr size_t UNIT = 64 * MiB;
constexpr size_t WS_END = WS_ARENA + 7 * UNIT + 1 * MiB;
#define ARENA(i) (WS_ARENA + (size_t)(i) * UNIT)
constexpr int CW_BAR = 4096;
constexpr int CW_CNT = 8192;

constexpr int RING_OFF = 0, RING_BYTES = 131072;
constexpr int EPI_OFF = 131072;
constexpr int MISC_OFF = 163840 - 512;
constexpr int LDS_BYTES = 163840;

__device__ __forceinline__ unsigned f2bf(float f) { unsigned u = __builtin_bit_cast(unsigned, f); return (u + 0x7fffu + ((u >> 16) & 1u)) >> 16; }
__device__ __forceinline__ float bflo(unsigned w) { return __builtin_bit_cast(float, w << 16); }
__device__ __forceinline__ float bfhi(unsigned w) { return __builtin_bit_cast(float, w & 0xffff0000u); }
__device__ __forceinline__ unsigned cvt_pk_bf16(float lo, float hi) { unsigned r; asm volatile("v_cvt_pk_bf16_f32 %0, %1, %2" : "=v"(r) : "v"(lo), "v"(hi)); return r; }
typedef __bf16 bf16x2_hw __attribute__((ext_vector_type(2)));
__device__ __forceinline__ unsigned cvt2(float lo, float hi) { const f32x2 v = {lo, hi}; const bf16x2_hw b = __builtin_convertvector(v, bf16x2_hw); return __builtin_bit_cast(unsigned, b); }
__device__ __forceinline__ unsigned pk2(float lo, float hi) { return cvt2(lo, hi); }
__device__ __forceinline__ float wave_sum(float v) {
#pragma unroll
    for (int o = 1; o < 64; o <<= 1) v += __shfl_xor(v, o);
    return v;
}
template <int CTRL> __device__ __forceinline__ float dppf(float v) { return __builtin_bit_cast(float, __builtin_amdgcn_update_dpp(0, __builtin_bit_cast(int, v), CTRL, 0xf, 0xf, true)); }
__device__ __forceinline__ float row16_sum(float v) { v += dppf<0xB1>(v); v += dppf<0x4E>(v); v += dppf<0x141>(v); v += dppf<0x140>(v); return v; }
__device__ __forceinline__ float sigmoidf_(float x) { return __builtin_amdgcn_rcpf(1.0f + __expf(-x)); }

#define XB_TMO      128
#define XB_XCNT(j)  (256  + 64 * (j))
#define XB_XSUB(j)  (1280 + 64 * (j))
#define XB_XGEN(j)  (2304 + 64 * (j))
#define XB_TOP      3328
#define XB_TOPGEN   3392
#define XCD_BAR_WORDS 3456
#define XB_SPIN_CAP (1u << 18)
__device__ __forceinline__ unsigned xb_ld(unsigned* p)              { return __hip_atomic_load(p, __ATOMIC_RELAXED, __HIP_MEMORY_SCOPE_AGENT); }
__device__ __forceinline__ unsigned xb_add(unsigned* p, unsigned v) { return __hip_atomic_fetch_add(p, v, __ATOMIC_RELAXED, __HIP_MEMORY_SCOPE_AGENT); }
__device__ __forceinline__ unsigned xb_xcc_id() { return (unsigned)__builtin_amdgcn_s_getreg((3 << 11) | 20) & 0xFu; }
#define XB_SPIN(cond, bar) do { unsigned _sp = 0; while (cond) { __builtin_amdgcn_s_sleep(1); \
    if ((++_sp & 255u) == 0u) { if (xb_ld(&(bar)[XB_TMO])) break; if (_sp > XB_SPIN_CAP) { atomicAdd(&(bar)[XB_TMO], 1u); break; } } } } while (0)
struct XcdBarrier { unsigned* bar; unsigned x; volatile LAS unsigned* st; };
__device__ __forceinline__ XcdBarrier xcd_barrier_post(unsigned* bar, volatile LAS unsigned* st) {
    XcdBarrier b; b.bar = bar; b.x = xb_xcc_id(); b.st = st;
    if (threadIdx.x == 0) (void)xb_add(&bar[XB_XCNT(b.x)], 1u);
    return b;
}
__device__ __forceinline__ void xcd_barrier_complete(unsigned* bar, unsigned x, unsigned& nloc, unsigned& nx) {
    const unsigned G = gridDim.x * gridDim.y * gridDim.z;
    unsigned sum, cnt, mine, sp = 0u;
    for (;;) {
        sum = 0u; cnt = 0u; mine = 0u;
#pragma unroll
        for (unsigned j = 0; j < 16; ++j) { const unsigned c = xb_ld(&bar[XB_XCNT(j)]); sum += c; cnt += (c > 0u) ? 1u : 0u; mine = (j == x) ? c : mine; }
        if (sum == G) break;
        __builtin_amdgcn_s_sleep(1);
        if ((++sp & 255u) == 0u) { if (xb_ld(&bar[XB_TMO])) break; if (sp > XB_SPIN_CAP) { atomicAdd(&bar[XB_TMO], 1u); break; } }
    }
    nloc = mine > 0u ? mine : 1u; nx = cnt > 0u ? cnt : 1u;
}
__device__ __forceinline__ void xcd_barrier(const XcdBarrier& b) {
    asm volatile("s_waitcnt vmcnt(0)" ::: "memory");
    __syncthreads();
    if (threadIdx.x == 0) {
        unsigned* bar = b.bar;
        __builtin_amdgcn_s_waitcnt(0);
        unsigned nloc = b.st[0], nx = b.st[1];
        if (nloc == 0u) { xcd_barrier_complete(bar, b.x, nloc, nx); b.st[0] = nloc; b.st[1] = nx; }
        const unsigned old = xb_add(&bar[XB_XSUB(b.x)], 1u);
        const unsigned gen = old / nloc;
        if (old + 1u == (gen + 1u) * nloc) {
            __builtin_amdgcn_fence(__ATOMIC_RELEASE, "agent");
            asm volatile("s_waitcnt vmcnt(0)" ::: "memory");
            const unsigned og = xb_add(&bar[XB_TOP], 1u);
            const unsigned tg = og / nx;
            if (og + 1u == (tg + 1u) * nx) xb_add(&bar[XB_TOPGEN], 1u);
            else XB_SPIN(xb_ld(&bar[XB_TOPGEN]) == tg, bar);
            __builtin_amdgcn_fence(__ATOMIC_ACQUIRE, "agent");
            xb_add(&bar[XB_XGEN(b.x)], 1u);
            asm volatile("s_waitcnt vmcnt(0)" ::: "memory");
        } else {
            XB_SPIN(xb_ld(&bar[XB_XGEN(b.x)]) == gen, bar);
            __builtin_amdgcn_fence(__ATOMIC_ACQUIRE, "agent");
            asm volatile("s_waitcnt vmcnt(0)" ::: "memory");
        }
    }
    __syncthreads();
}

namespace pg8 {
constexpr int BM = 256, BK = 64, HALF = 128, HTB = HALF * BK * 2, STAGE_BYTES = 8 * HTB;
__host__ __device__ __forceinline__ int lds_byte(int r, int c) { const int st = (r >> 4) * 2 + (c >> 5), rr = r & 15, cc = c & 31, ob = rr * 64 + cc * 2; return st * 1024 + (ob ^ (((ob >> 9) & 1) << 5)); }
__host__ __device__ __forceinline__ void stage_rc(int b, int& R, int& C) { const int st = b / 1024, sb = b % 1024, swz = sb ^ (((sb >> 9) & 1) << 5); R = (st >> 1) * 16 + swz / 64; C = (st & 1) * 32 + (swz % 64) / 2; }
__host__ __device__ __forceinline__ int invperm32(int j) { return 16 * ((j >> 2) & 1) + 4 * ((j >> 3) & 3) + (j & 3); }

struct GUnit { const char* A; const char* B; int r0, c0, job, aux; };
struct GemmCfg { int lda, ldb, K, kj_tile, kj_bytes; };
typedef f32x4 Acc[2][2][4][2];

__device__ __forceinline__ void tile_of(int wgid, int nM, int nN, int& pm, int& pn) {
    const int nwg = nM * nN;
    { const int q = nwg / 8, r = nwg % 8, xcd = wgid % 8, off = wgid / 8; wgid = (xcd < r ? xcd * (q + 1) : r * (q + 1) + (xcd - r) * q) + off; }
    const int nig = 8 * nN, gid = wgid / nig, fm = gid * 8, gsz = (nM - fm) < 8 ? (nM - fm) : 8;
    pm = fm + ((wgid % nig) % gsz); pn = (wgid % nig) / gsz;
}

template <class Epi, class Sched>
__device__ __forceinline__ void gemm_phase(LAS unsigned char* lds, const GemmCfg g, const Sched& S, const Epi& E) {
    int tid = threadIdx.x; asm volatile("" : "+v"(tid));
    const int wid = __builtin_amdgcn_readfirstlane(tid >> 6), lane = tid & 63, wr = wid >> 2, wc = wid & 3, fr = lane & 15, fq = lane >> 4;
    const int nt = g.K / BK;
    unsigned voffB[2];
#pragma unroll
    for (int i = 0; i < 2; ++i) { int R_, C_; stage_rc(tid * 16 + i * 8192, R_, C_); voffB[i] = (unsigned)(R_ * g.ldb + C_) * 2u; }
    const size_t hstepB = (size_t)HALF * g.ldb * 2, hstepA = Sched::GATHER ? (size_t)0 : (size_t)HALF * g.lda * 2;
    const unsigned ldsw = (unsigned)wid * 1024u;
    const int aoff = lds_byte(wr * 64 + fr, fq * 8), boff = lds_byte(wc * 32 + fr, fq * 8);
#define PG8_SA(b, h) (((b) * 2 + (h)) * HTB)
#define PG8_SB(b, h) ((4 + (b) * 2 + (h)) * HTB)
#define PG8_STAGE2(bufoff, gbase, v0, v1) do { \
        __builtin_amdgcn_global_load_lds((const unsigned*)((const char*)(gbase) + (v0)), (LAS unsigned*)(lds + (bufoff) + ldsw), 16, 0, 0); \
        __builtin_amdgcn_global_load_lds((const unsigned*)((const char*)(gbase) + (v1)), (LAS unsigned*)(lds + (bufoff) + ldsw + 8192), 16, 0, 0); } while (0)
#define PG8_LDA(dst, b, h) do { _Pragma("unroll") for (int m = 0; m < 4; ++m) _Pragma("unroll") for (int k = 0; k < 2; ++k) dst[m][k] = *(const LAS bf16x8*)(lds + PG8_SA(b, h) + aoff + m * 2048 + k * 1024); } while (0)
#define PG8_LDB(dst, b, h) do { _Pragma("unroll") for (int n = 0; n < 2; ++n) _Pragma("unroll") for (int k = 0; k < 2; ++k) dst[n][k] = *(const LAS bf16x8*)(lds + PG8_SB(b, h) + boff + n * 2048 + k * 1024); } while (0)
#define PG8_MMA(ai, bj, At, Bt) do { __builtin_amdgcn_s_setprio(1); _Pragma("unroll") for (int m = 0; m < 4; ++m) _Pragma("unroll") for (int n = 0; n < 2; ++n) _Pragma("unroll") for (int k = 0; k < 2; ++k) \
        acc[ai][bj][m][n] = __builtin_amdgcn_mfma_f32_16x16x32_bf16(Bt[n][k], At[m][k], acc[ai][bj][m][n], 0, 0, 0); __builtin_amdgcn_s_setprio(0); } while (0)
#define PG8_WAIT_V(n) asm volatile("s_waitcnt vmcnt(" #n ")" ::: "memory")
#define PG8_WAIT_L(n) asm volatile("s_waitcnt lgkmcnt(" #n ")" ::: "memory")
#define PG8_BAR __builtin_amdgcn_s_barrier()
#define PG8_SCHED __builtin_amdgcn_sched_barrier(0)
#define PG8_KOFF(kt) ((size_t)(kt) * 128 - (((kt) >= g.kj_tile) ? (size_t)g.kj_bytes : (size_t)0))
    GUnit cur, nxt; int ui = 0;
    if (!S.next(0, cur)) return;
    Acc acc;
#pragma unroll
    for (int a = 0; a < 2; ++a)
#pragma unroll
        for (int b = 0; b < 2; ++b)
#pragma unroll
            for (int m = 0; m < 4; ++m)
#pragma unroll
                for (int n = 0; n < 2; ++n) acc[a][b][m][n] = (f32x4){0.f, 0.f, 0.f, 0.f};
    bf16x8 At[4][2], B0[2][2], B1[2][2];
    unsigned vA00, vA01, vA10, vA11;
    unsigned vN00 = 0, vN01 = 0, vN10 = 0, vN11 = 0;
    S.aoff(cur, g, tid, vA00, vA01, vA10, vA11);
    const char* cA = cur.A; const char* cB = cur.B;
    PG8_STAGE2(PG8_SB(0, 0), cB, voffB[0], voffB[1]); PG8_STAGE2(PG8_SB(0, 1), cB + hstepB, voffB[0], voffB[1]);
    PG8_STAGE2(PG8_SA(0, 0), cA, vA00, vA01); PG8_STAGE2(PG8_SA(0, 1), cA + hstepA, vA10, vA11);
    if (wr == 1) PG8_BAR;
    PG8_WAIT_V(2); PG8_BAR;
    PG8_STAGE2(PG8_SB(1, 0), cB + 128, voffB[0], voffB[1]); PG8_STAGE2(PG8_SA(1, 0), cA + PG8_KOFF(1), vA00, vA01); PG8_STAGE2(PG8_SB(1, 1), cB + hstepB + 128, voffB[0], voffB[1]);
    PG8_WAIT_V(6); PG8_BAR;
    for (;;) {
        const bool has_next = S.next(ui + 1, nxt);
        if constexpr (Sched::GATHER) { if (has_next) S.aoff(nxt, g, tid, vN00, vN01, vN10, vN11); else { vN00 = vA00; vN01 = vA01; vN10 = vA10; vN11 = vA11; }
            asm volatile("" : "+v"(vN00), "+v"(vN01), "+v"(vN10), "+v"(vN11) :: "memory"); }
        const char* nA = has_next ? nxt.A : cA; const char* nB = has_next ? nxt.B : cB;
        for (int t = 0; t < nt; t += 2) {
            const bool last = (t == nt - 2);
            const char* a1 = cA + PG8_KOFF(t + 1);
            const char* a2 = last ? nA : cA + PG8_KOFF(t + 2); const char* b2 = last ? nB : cB + (size_t)(t + 2) * 128;
            const char* a3 = last ? nA + PG8_KOFF(1) : cA + PG8_KOFF(t + 3); const char* b3 = b2 + 128;
            unsigned w00 = vA00, w01 = vA01, w10 = vA10, w11 = vA11;
            if constexpr (Sched::GATHER) { w00 = last ? vN00 : vA00; w01 = last ? vN01 : vA01; w10 = last ? vN10 : vA10; w11 = last ? vN11 : vA11; }
            PG8_LDB(B0, 0, 0); PG8_LDB(B1, 0, 1); PG8_SCHED; PG8_LDA(At, 0, 0); PG8_STAGE2(PG8_SA(1, 1), a1 + hstepA, vA10, vA11);
            PG8_WAIT_V(8); PG8_WAIT_L(0); PG8_BAR; PG8_MMA(0, 0, At, B0); PG8_MMA(0, 1, At, B1); PG8_BAR; PG8_SCHED;
            PG8_LDA(At, 0, 1); PG8_STAGE2(PG8_SB(0, 0), b2, voffB[0], voffB[1]); PG8_STAGE2(PG8_SB(0, 1), b2 + hstepB, voffB[0], voffB[1]); PG8_STAGE2(PG8_SA(0, 0), a2, w00, w01);
            PG8_WAIT_V(8); PG8_WAIT_L(0); PG8_BAR; PG8_MMA(1, 0, At, B0); PG8_MMA(1, 1, At, B1); PG8_BAR; PG8_SCHED;
            PG8_LDB(B0, 1, 0); PG8_LDB(B1, 1, 1); PG8_SCHED; PG8_LDA(At, 1, 0); PG8_STAGE2(PG8_SA(0, 1), a2 + hstepA, w10, w11);
            PG8_WAIT_V(8); PG8_WAIT_L(0); PG8_BAR; PG8_MMA(0, 0, At, B0); PG8_MMA(0, 1, At, B1); PG8_BAR; PG8_SCHED;
            PG8_LDA(At, 1, 1); PG8_STAGE2(PG8_SB(1, 0), b3, voffB[0], voffB[1]); PG8_STAGE2(PG8_SB(1, 1), b3 + hstepB, voffB[0], voffB[1]); PG8_STAGE2(PG8_SA(1, 0), a3, w00, w01);
            PG8_WAIT_V(8); PG8_WAIT_L(0); PG8_BAR; PG8_MMA(1, 0, At, B0); PG8_MMA(1, 1, At, B1); PG8_BAR; PG8_SCHED;
        }
        if (wr == 0) PG8_BAR;
        E(acc, cur, wr, wc, fr, fq);
        if (!has_next) break;
#pragma unroll
        for (int a = 0; a < 2; ++a)
#pragma unroll
            for (int b = 0; b < 2; ++b)
#pragma unroll
                for (int m = 0; m < 4; ++m)
#pragma unroll
                    for (int n = 0; n < 2; ++n) acc[a][b][m][n] = (f32x4){0.f, 0.f, 0.f, 0.f};
        cur = nxt; cA = nA; cB = nB; ++ui;
        if constexpr (Sched::GATHER) { vA00 = vN00; vA01 = vN01; vA10 = vN10; vA11 = vN11; }
        if (wr == 1) PG8_BAR;
    }
    PG8_WAIT_V(0);
    PG8_BAR;
#undef PG8_SA
#undef PG8_SB
#undef PG8_STAGE2
#undef PG8_LDA
#undef PG8_LDB
#undef PG8_MMA
#undef PG8_WAIT_V
#undef PG8_WAIT_L
#undef PG8_BAR
#undef PG8_SCHED
#undef PG8_KOFF
}
__device__ __forceinline__ void dense_aoff(const GemmCfg& g, int tid, unsigned& v00, unsigned& v01, unsigned& v10, unsigned& v11) {
    int R0, C0, R1, C1; stage_rc(tid * 16, R0, C0); stage_rc(tid * 16 + 8192, R1, C1);
    v00 = (unsigned)(R0 * g.lda + C0) * 2u; v01 = (unsigned)(R1 * g.lda + C1) * 2u; v10 = v00; v11 = v01;
}
}
using pg8::GUnit; using pg8::GemmCfg; using pg8::Acc;

#define FOR_AI_M _Pragma("unroll") for (int ai = 0; ai < 2; ++ai) _Pragma("unroll") for (int m = 0; m < 4; ++m)
#define FOR_BJ _Pragma("unroll") for (int bj = 0; bj < 2; ++bj)

__device__ __forceinline__ v4u pack8(const f32x4& a, const f32x4& b) { v4u w; w.x = cvt_pk_bf16(a[0], a[1]); w.y = cvt_pk_bf16(a[2], a[3]); w.z = cvt_pk_bf16(b[0], b[1]); w.w = cvt_pk_bf16(b[2], b[3]); return w; }
__device__ __forceinline__ v2u pack4(const f32x4& a) { v2u w; w.x = cvt_pk_bf16(a[0], a[1]); w.y = cvt_pk_bf16(a[2], a[3]); return w; }

struct EpiStore {
    bf16* O; int ldo; size_t strideO; bool nat;
    __device__ __forceinline__ void operator()(Acc& acc, const GUnit& u, int wr, int wc, int fr, int fq) const {
        bf16* o = O + (size_t)u.job * strideO;
        const int row0 = u.r0 + wr * 64 + fr;
        if (!nat) {
            const int col0 = u.c0 + wc * 32 + 8 * fq;
            FOR_AI_M { bf16* rowp = o + (size_t)(row0 + ai * 128 + m * 16) * ldo + col0;
                FOR_BJ *(v4u*)(rowp + bj * 128) = pack8(acc[ai][bj][m][0], acc[ai][bj][m][1]); }
        } else {
            const int col0 = u.c0 + wc * 32 + 4 * fq;
            FOR_AI_M { bf16* rowp = o + (size_t)(row0 + ai * 128 + m * 16) * ldo + col0;
                FOR_BJ { *(v2u*)(rowp + bj * 128) = pack4(acc[ai][bj][m][0]); *(v2u*)(rowp + bj * 128 + 16) = pack4(acc[ai][bj][m][1]); } }
        }
    }
};
struct EpiLoraDown {
    bf16* O;
    __device__ __forceinline__ void operator()(Acc& acc, const GUnit& u, int wr, int wc, int fr, int fq) const {
        const int row0 = u.r0 + wr * 64 + fr, col0 = wc * 32 + 8 * fq;
        FOR_AI_M { bf16* rowp = O + (size_t)(row0 + ai * 128 + m * 16) * 256 + col0;
            FOR_BJ { f32x4 v0 = acc[ai][bj][m][0], v1 = acc[ai][bj][m][1];
                if (bj == 1) {
#pragma unroll
                    for (int i = 0; i < 4; ++i) { v0[i] = sigmoidf_(v0[i]); v1[i] = sigmoidf_(v1[i]); }
                } else if (wc < 2) {
#pragma unroll
                    for (int i = 0; i < 4; ++i) { v0[i] = 1.0f - 2.0f * __builtin_amdgcn_rcpf(1.0f + __expf(2.0f * v0[i])); v1[i] = 1.0f - 2.0f * __builtin_amdgcn_rcpf(1.0f + __expf(2.0f * v1[i])); }
                }
                *(v4u*)(rowp + bj * 128) = pack8(v0, v1); } }
    }
};
struct EpiLoraUp {
    bf16* LD; bf16* AA; bf16* GG; const float* w0; const float* a0;
    __device__ __forceinline__ void operator()(Acc& acc, const GUnit& u, int wr, int wc, int fr, int fq) const {
        const int kind = u.c0 >> 10, cbase = (u.c0 & 1023) + wc * 32 + 8 * fq;
        bf16* o = LD + (size_t)kind * (UNIT / 2);
        const float* bias = w0; if (kind == 1) bias = a0;
        const int row0 = u.r0 + wr * 64 + fr;
        f32x4 bv[2][2];
        FOR_BJ { bv[bj][0] = kind < 2 ? *(const f32x4*)(bias + cbase + bj * 128) : (f32x4){0.f, 0.f, 0.f, 0.f}; bv[bj][1] = kind < 2 ? *(const f32x4*)(bias + cbase + bj * 128 + 4) : (f32x4){0.f, 0.f, 0.f, 0.f}; }
        FOR_AI_M { bf16* rowp = o + (size_t)(row0 + ai * 128 + m * 16) * DM + cbase;
            FOR_BJ { f32x4 v0 = acc[ai][bj][m][0] + bv[bj][0], v1 = acc[ai][bj][m][1] + bv[bj][1];
                if (kind == 0) {
#pragma unroll
                    for (int i = 0; i < 4; ++i) { v0[i] = -0.6065306597126334f * sigmoidf_(v0[i]); v1[i] = -0.6065306597126334f * sigmoidf_(v1[i]); }
                } else if (kind == 1) {
#pragma unroll
                    for (int i = 0; i < 4; ++i) { v0[i] = sigmoidf_(v0[i]); v1[i] = sigmoidf_(v1[i]); }
                }
                *(v4u*)(rowp + bj * 128) = pack8(v0, v1); } }
    }
};
template <bool NORM, bool SRC32> struct EpiResidual {
    const void* src; bf16* X; int jobrows; float* SSQ; LAS float* xch;
    __device__ __forceinline__ void ld8(size_t off, f32x4& a, f32x4& b) const {
        if (SRC32) { a = *(const f32x4*)((const float*)src + off); b = *(const f32x4*)((const float*)src + off + 4); }
        else { const v4u w = *(const v4u*)((const bf16*)src + off); a = (f32x4){bflo(w.x), bfhi(w.x), bflo(w.y), bfhi(w.y)}; b = (f32x4){bflo(w.z), bfhi(w.z), bflo(w.w), bfhi(w.w)}; }
    }
    __device__ __forceinline__ void operator()(Acc& acc, const GUnit& u, int wr, int wc, int fr, int fq) const {
        const int row0 = u.job * jobrows + u.r0 + wr * 64 + fr, col0 = u.c0 + wc * 32 + 8 * fq;
        f32x4 cur[4], nxt[4];
#define ER_LOAD(dst, g) do { const size_t off_ = (size_t)(row0 + ((g) >> 2) * 128 + ((g) & 3) * 16) * DM + col0; \
            ld8(off_, dst[0], dst[1]); ld8(off_ + 128, dst[2], dst[3]); } while (0)
        ER_LOAD(cur, 0);
#pragma unroll
        for (int g = 0; g < 8; ++g) {
            const int ai = g >> 2, m = g & 3;
            if (g + 1 < 8) ER_LOAD(nxt, g + 1);
            const size_t off = (size_t)(row0 + ai * 128 + m * 16) * DM + col0; float q = 0.f;
#pragma unroll
            for (int bj = 0; bj < 2; ++bj) { const f32x4 x0 = cur[bj * 2] + acc[ai][bj][m][0], x1 = cur[bj * 2 + 1] + acc[ai][bj][m][1];
                *(v4u*)(X + off + bj * 128) = pack8(x0, x1);
                if (NORM) q += ((x0[0] * x0[0] + x0[1] * x0[1]) + (x0[2] * x0[2] + x0[3] * x0[3])) + ((x1[0] * x1[0] + x1[1] * x1[1]) + (x1[2] * x1[2] + x1[3] * x1[3])); }
            if (NORM) { q += __shfl_xor(q, 16); q += __shfl_xor(q, 32); if (fq == 0) xch[(ai * 128 + wr * 64 + m * 16 + fr) * 4 + wc] = q; }
            asm volatile("" ::: "memory");
#pragma unroll
            for (int i = 0; i < 4; ++i) cur[i] = nxt[i];
        }
#undef ER_LOAD
        if (NORM) {
            LDS_WAIT(); __builtin_amdgcn_s_barrier(); asm volatile("" ::: "memory");
            const int t = threadIdx.x;
            if (t < 256) { const f32x4 p = *(const LAS f32x4*)(xch + t * 4); SSQ[(size_t)(u.job * jobrows + u.r0 + t) * 4 + (u.c0 >> 8)] = (p[0] + p[1]) + (p[2] + p[3]); }
            LDS_WAIT(); __builtin_amdgcn_s_barrier(); asm volatile("" ::: "memory");
        }
    }
};
constexpr float ATT_C2 = 0.125f * 1.4426950408889634f;
struct EpiQKVRope {
    bf16* Q; bf16* K; bf16* V; const f32x2* rope; const float* rinv;
    __device__ __forceinline__ void operator()(Acc& acc, const GUnit& u, int wr, int wc, int fr, int fq) const {
        const int kind = u.c0 >> 10, ct = u.c0 & 1023;
        const int row0 = u.r0 + wr * 64 + fr;
        if (kind == 2) {
            const int col0 = ct + wc * 32 + 8 * fq;
            FOR_AI_M { bf16* rowp = V + (size_t)(row0 + ai * 128 + m * 16) * DM + col0; const float ri = rinv[row0 + ai * 128 + m * 16];
                FOR_BJ *(v4u*)(rowp + bj * 128) = pack8(acc[ai][bj][m][0] * ri, acc[ai][bj][m][1] * ri); }
        } else {
            bf16* o = kind == 0 ? Q : K; const float sc0 = kind == 0 ? ATT_C2 : 1.0f;
            const int col0 = ct + wc * 64 + 8 * fq;
            FOR_AI_M { const int row = row0 + ai * 128 + m * 16; const float sc = sc0 * rinv[row];
                const f32x4* rp = (const f32x4*)(rope + (size_t)row * 32 + 8 * fq);
                const f32x4 t0 = rp[0], t1 = rp[1], t2 = rp[2], t3 = rp[3];
                const float cs[8] = {t0[0], t0[2], t1[0], t1[2], t2[0], t2[2], t3[0], t3[2]};
                const float sn[8] = {t0[1], t0[3], t1[1], t1[3], t2[1], t2[3], t3[1], t3[3]};
                f32x4 lo0, lo1, hi0, hi1;
#pragma unroll
                for (int i = 0; i < 4; ++i) {
                    const float x1a = acc[ai][0][m][0][i], x2a = acc[ai][1][m][0][i], x1b = acc[ai][0][m][1][i], x2b = acc[ai][1][m][1][i];
                    lo0[i] = (x1a * cs[i] - x2a * sn[i]) * sc; hi0[i] = (x2a * cs[i] + x1a * sn[i]) * sc;
                    lo1[i] = (x1b * cs[4 + i] - x2b * sn[4 + i]) * sc; hi1[i] = (x2b * cs[4 + i] + x1b * sn[4 + i]) * sc; }
                bf16* rowp = o + (size_t)row * DM + col0;
                *(v4u*)(rowp) = pack8(lo0, lo1); *(v4u*)(rowp + 32) = pack8(hi0, hi1); }
        }
    }
};
struct EpiSoftmax {
    bf16* P; LAS float* xch; const float* SSQ;
    __device__ __forceinline__ void operator()(Acc& acc, const GUnit& u, int wr, int wc, int fr, int fq) const {
        constexpr float SC = 0.0625f * 1.4426950408889634f;
        LAS float* Mx = xch; LAS float* Sx = xch + 1024;
        FOR_AI_M { const f32x4 q = *(const f32x4*)(SSQ + (size_t)(u.r0 + ai * 128 + wr * 64 + m * 16 + fr) * 4);
            const float ri = __builtin_amdgcn_rsqf(((q[0] + q[1]) + (q[2] + q[3])) * (1.0f / DM) + RMS_EPS);
            FOR_BJ { acc[ai][bj][m][0] = acc[ai][bj][m][0] * ri; acc[ai][bj][m][1] = acc[ai][bj][m][1] * ri; } }
        FOR_AI_M { float v = -INFINITY;
            FOR_BJ {
#pragma unroll
                for (int n = 0; n < 2; ++n) { const f32x4 x = acc[ai][bj][m][n]; v = fmaxf(v, fmaxf(fmaxf(x[0], x[1]), fmaxf(x[2], x[3]))); } }
            v = fmaxf(v, __shfl_xor(v, 16)); v = fmaxf(v, __shfl_xor(v, 32));
            if (fq == 0) Mx[(ai * 128 + wr * 64 + m * 16 + fr) * 4 + wc] = v; }
        LDS_WAIT(); __builtin_amdgcn_s_barrier(); asm volatile("" ::: "memory");
        FOR_AI_M { const f32x4 q = *(const LAS f32x4*)(Mx + (ai * 128 + wr * 64 + m * 16 + fr) * 4);
            const float mm = fmaxf(fmaxf(q[0], q[1]), fmaxf(q[2], q[3])) * SC; float s = 0.f;
            FOR_BJ {
#pragma unroll
                for (int n = 0; n < 2; ++n) { f32x4 x = acc[ai][bj][m][n];
#pragma unroll
                    for (int i = 0; i < 4; ++i) { x[i] = __builtin_amdgcn_exp2f(x[i] * SC - mm); s += x[i]; }
                    acc[ai][bj][m][n] = x; } }
            s += __shfl_xor(s, 16); s += __shfl_xor(s, 32);
            if (fq == 0) Sx[(ai * 128 + wr * 64 + m * 16 + fr) * 4 + wc] = s; }
        LDS_WAIT(); __builtin_amdgcn_s_barrier(); asm volatile("" ::: "memory");
        const int row0 = u.r0 + wr * 64 + fr, col0 = u.c0 + wc * 32 + 4 * fq;
        FOR_AI_M { const f32x4 q = *(const LAS f32x4*)(Sx + (ai * 128 + wr * 64 + m * 16 + fr) * 4);
            const float inv = __builtin_amdgcn_rcpf((q[0] + q[1]) + (q[2] + q[3]));
            bf16* rowp = P + (size_t)(row0 + ai * 128 + m * 16) * DM + col0;
            FOR_BJ { *(v2u*)(rowp + bj * 128) = pack4(acc[ai][bj][m][0] * inv); *(v2u*)(rowp + bj * 128 + 16) = pack4(acc[ai][bj][m][1] * inv); } }
        LDS_WAIT(); __builtin_amdgcn_s_barrier(); asm volatile("" ::: "memory");
    }
};
struct EpiMoE1 {
    bf16* H; const int* pairlist; const float* rinv;
    __device__ __forceinline__ void operator()(Acc& acc, const GUnit& u, int wr, int wc, int fr, int fq) const {
        const int e = u.job, n_e = u.aux;
        const int col0 = u.c0 + wc * 32 + 8 * fq;
        int pr_[2][4]; float ri_[2][4];
        FOR_AI_M { const int rank = u.r0 + ai * 128 + wr * 64 + m * 16 + fr; pr_[ai][m] = rank < n_e ? pairlist[(size_t)e * PLCAP + rank] : 0; }
        FOR_AI_M ri_[ai][m] = rinv[pr_[ai][m] >> 1];
        FOR_AI_M { const int rank = u.r0 + ai * 128 + wr * 64 + m * 16 + fr;
            if (rank < n_e) { const int pair = pr_[ai][m]; const float ri = ri_[ai][m];
                f32x4 h0, h1;
#pragma unroll
                for (int i = 0; i < 4; ++i) { const float a0 = acc[ai][0][m][0][i] * ri, a1 = acc[ai][0][m][1][i] * ri;
                    h0[i] = a0 * sigmoidf_(a0) * (acc[ai][1][m][0][i] * ri); h1[i] = a1 * sigmoidf_(a1) * (acc[ai][1][m][1][i] * ri); }
                *(v4u*)(H + (size_t)pair * FF + col0) = pack8(h0, h1); } }
    }
};
constexpr float Y_SCALE = 16.0f;
__device__ __forceinline__ unsigned pk4_fp8(const f32x4& v) { int w = 0; w = __builtin_amdgcn_cvt_pk_fp8_f32(v[0], v[1], w, false); w = __builtin_amdgcn_cvt_pk_fp8_f32(v[2], v[3], w, true); return (unsigned)w; }
struct EpiMoE2 {
    unsigned char* Y; const int* pairlist; const float* gate;
    __device__ __forceinline__ void operator()(Acc& acc, const GUnit& u, int wr, int wc, int fr, int fq) const {
        const int e = u.job, n_e = u.aux;
        const int col0 = u.c0 + wc * 64 + 16 * fq;
        int pr_[2][4]; float gt_[2][4];
        FOR_AI_M { const int rank = u.r0 + ai * 128 + wr * 64 + m * 16 + fr; pr_[ai][m] = rank < n_e ? pairlist[(size_t)e * PLCAP + rank] : 0; }
        FOR_AI_M gt_[ai][m] = gate[pr_[ai][m]];
        FOR_AI_M { const int rank = u.r0 + ai * 128 + wr * 64 + m * 16 + fr;
            if (rank < n_e) { const int pair = pr_[ai][m]; const float gt = gt_[ai][m] * Y_SCALE;
                unsigned char* rowp = Y + (size_t)pair * DM + col0;
                v4u w; w.x = pk4_fp8(acc[ai][0][m][0] * gt); w.y = pk4_fp8(acc[ai][0][m][1] * gt); w.z = pk4_fp8(acc[ai][1][m][0] * gt); w.w = pk4_fp8(acc[ai][1][m][1] * gt);
                *(v4u*)rowp = w; } }
    }
};

struct BatchSched {
    static constexpr bool GATHER = false;
    int G, c, nb, nM, nN, lda, ldb; const char* A; const char* B; size_t strideA, strideB; bool plain;
    __device__ __forceinline__ bool next(int i, GUnit& u) const {
        const int L = i * G + c, per = nM * nN; if (L >= nb * per) return false;
        const int s = L / per; int pm, pn; if (plain) { pm = (L - s * per) / nN; pn = (L - s * per) % nN; } else pg8::tile_of(L - s * per, nM, nN, pm, pn);
        u.A = A + (size_t)s * strideA + (size_t)pm * 256 * lda * 2; u.B = B + (size_t)s * strideB + (size_t)pn * 256 * ldb * 2; u.r0 = pm * 256; u.c0 = pn * 256; u.job = s; u.aux = 0; return true;
    }
    __device__ __forceinline__ void aoff(const GUnit&, const GemmCfg& g, int tid, unsigned& v00, unsigned& v01, unsigned& v10, unsigned& v11) const { pg8::dense_aoff(g, tid, v00, v01, v10, v11); }
};
struct LoraDownSched {
    static constexpr bool GATHER = false;
    int G, c; const char* hp; const char* B;
    __device__ __forceinline__ bool next(int i, GUnit& u) const {
        const int L = i * G + c; if (L >= NTOK / 256) return false;
        const int b = L / (SEQ / 256), t0 = (L % (SEQ / 256)) * 256;
        u.A = hp + ((size_t)b * (SEQ + 1) + 1 + t0) * DM * 2; u.B = B; u.r0 = L * 256; u.c0 = 0; u.job = 0; u.aux = 0; return true;
    }
    __device__ __forceinline__ void aoff(const GUnit&, const GemmCfg& g, int tid, unsigned& v00, unsigned& v01, unsigned& v10, unsigned& v11) const { pg8::dense_aoff(g, tid, v00, v01, v10, v11); }
};
struct XAttnSched {
    static constexpr bool GATHER = false;
    int G, c, mode; const char* A; const char* B;
    __device__ __forceinline__ bool next(int i, GUnit& u) const {
        const int L = i * G + c; u.aux = 0;
        if (mode == 2) { if (L >= BATCH * MEMH * (SEQ / 256)) return false;
            const int tt = L % (SEQ / 256), bh = L / (SEQ / 256), h = bh % MEMH, b = bh / MEMH;
            u.A = A + ((size_t)b * SEQ + tt * 256) * DM * 2; u.B = B + (size_t)bh * MEMT * DM * 2; u.r0 = b * SEQ + tt * 256; u.c0 = h * 256; u.job = 0; return true; }
        if (L >= BATCH * MEMH * 4) return false;
        const int q = L & 3, bh = L >> 2, h = bh % MEMH, b = bh / MEMH;
        if (mode == 0) { u.A = A + ((size_t)b * MEMT * DM + h * 256) * 2; u.B = B + ((size_t)q * 256 * DM + h * 256) * 2; u.r0 = 0; u.c0 = q * 256; u.job = bh; }
        else { u.A = A + ((size_t)q * 256 * DM + h * 256) * 2; u.B = B + ((size_t)b * MEMT * DM + h * 256) * 2; u.r0 = q * 256; u.c0 = h * 256; u.job = b; }
        return true;
    }
    __device__ __forceinline__ void aoff(const GUnit&, const GemmCfg& g, int tid, unsigned& v00, unsigned& v01, unsigned& v10, unsigned& v11) const { pg8::dense_aoff(g, tid, v00, v01, v10, v11); }
};
struct MoeSched {
    static constexpr bool GATHER = true;
    int G, c, shift, ncol, cstep; const char* A; const char* B; size_t bstride_e, bstride_n; const int* pairlist; const LAS int* tab;
    __device__ __forceinline__ bool next(int i, GUnit& u) const {
        const int L = i * G + c, pn = L % ncol, rt = L / ncol, lane = threadIdx.x & 63, q = lane & 31;
        const int n = tab[q], st = tab[32 + q];
        const unsigned long long hit = __ballot(lane < 32 && rt >= st && rt < st + ((n + 255) >> 8));
        if (hit == 0ull) return false;
        const int e = __builtin_ctzll(hit);
        const int n_e = __builtin_amdgcn_readlane(n, e), st_e = __builtin_amdgcn_readlane(st, e);
        u.A = A; u.B = B + (size_t)e * bstride_e + (size_t)pn * bstride_n; u.r0 = (rt - st_e) * 256; u.c0 = pn * cstep; u.job = e; u.aux = n_e; return true;
    }
    __device__ __forceinline__ void aoff(const GUnit& u, const GemmCfg& g, int tid, unsigned& v00, unsigned& v01, unsigned& v10, unsigned& v11) const {
        const int* pl = pairlist + (size_t)u.job * PLCAP + u.r0; const int lim = u.aux - u.r0;
        int sR[2], sC[2]; pg8::stage_rc(tid * 16, sR[0], sC[0]); pg8::stage_rc(tid * 16 + 8192, sR[1], sC[1]);
        const int r00 = sR[0], r01 = sR[1], r10 = pg8::HALF + sR[0], r11 = pg8::HALF + sR[1];
        const int p00 = r00 < lim ? pl[r00] >> shift : 0, p01 = r01 < lim ? pl[r01] >> shift : 0, p10 = r10 < lim ? pl[r10] >> shift : 0, p11 = r11 < lim ? pl[r11] >> shift : 0;
        v00 = (unsigned)(p00 * g.lda + sC[0]) * 2u; v01 = (unsigned)(p01 * g.lda + sC[1]) * 2u; v10 = (unsigned)(p10 * g.lda + sC[0]) * 2u; v11 = (unsigned)(p11 * g.lda + sC[1]) * 2u;
    }
};

namespace attn_body {
using bf16=__hip_bfloat16;
using bf16x8=__attribute__((ext_vector_type(8)))short;
using s16x4=__attribute__((ext_vector_type(4)))short;
using f32x16=__attribute__((ext_vector_type(16)))float;
using u32x4=__attribute__((ext_vector_type(4)))unsigned;
constexpr int NHEAD=16,SEQ=2048,D=64,DM=NHEAD*D;
constexpr int NW=8,QBLK=32,QB=QBLK*NW,KVBLK=64,NQB=SEQ/QB;
__device__ __forceinline__ int crow(int r,int hi){return (r&3)+8*(r>>2)+4*hi;}
#define SBAR() __builtin_amdgcn_sched_barrier(0)
__device__ __forceinline__ void cmask(f32x16&p0,f32x16&p1,int jb,int qrel,int hi){
  const float NEG=-INFINITY; int kb=64*jb+4*hi;
  #pragma unroll
  for(int r=0;r<16;++r){int kv=kb+(r&3)+8*(r>>2); if(kv>qrel)p0[r]=NEG; if(kv+32>qrel)p1[r]=NEG;}
}
__device__ __forceinline__ void allmask(f32x16&p0,f32x16&p1){
  const float NEG=-INFINITY;
  #pragma unroll
  for(int r=0;r<16;++r){p0[r]=NEG;p1[r]=NEG;}
}
constexpr int NSLOT=3, SLOTB=8192;
constexpr int LDS_K=0, LDS_V=NSLOT*SLOTB, LDS_WS=2*NSLOT*SLOTB, LDS_OST=LDS_WS+NW*64*4, LDS_BYTES=LDS_OST+NW*4096;
constexpr int LDS_KMEAN=86016;
constexpr float C2=0.125f*1.4426950408889634f;
__device__ __forceinline__ void glds16(const void*gsrc,unsigned lds_dst){unsigned keep;
  asm volatile("s_mov_b32 %0, m0\n\ts_mov_b32 m0, %2\n\ts_nop 0\n\tglobal_load_lds_dwordx4 %1, off\n\ts_mov_b32 m0, %0":"=&s"(keep):"v"(gsrc),"s"(lds_dst):"memory");}
__device__ __forceinline__ float max3f(float a,float b,float c){float r;asm("v_max3_f32 %0, %1, %2, %3":"=v"(r):"v"(a),"v"(b),"v"(c));return r;}
__device__ __forceinline__ float max2f(float a,float b){float r;asm("v_max_f32_e32 %0, %1, %2":"=v"(r):"v"(a),"v"(b));return r;}
__device__ __forceinline__ float fadd_s(float a,float b){float r;asm("v_add_f32_e32 %0, %1, %2":"=v"(r):"v"(a),"v"(b));return r;}
__device__ __forceinline__ float fsub_s(float a,float b){float r;asm("v_sub_f32_e32 %0, %1, %2":"=v"(r):"v"(a),"v"(b));return r;}
typedef float f32x2_t __attribute__((ext_vector_type(2))); typedef __bf16 bf16x2_t __attribute__((ext_vector_type(2)));
__device__ __forceinline__ unsigned cvtpk_s(float lo,float hi){f32x2_t v={lo,hi};bf16x2_t b=__builtin_convertvector(v,bf16x2_t);return __builtin_bit_cast(unsigned,b);}
#define WAIT_BAR(N) asm volatile("s_waitcnt vmcnt(" #N ") lgkmcnt(0)\n\ts_barrier":::"memory")
__device__ __forceinline__ void qkt(f32x16&p0,f32x16&p1,const char*Kslot,const bf16x8*qr,int r32,int hi){ const f32x16 negm=f32x16{};
  const char*kb=Kslot+hi*1024+r32*16;
  #pragma unroll
  for(int d0=0;d0<4;++d0){
    const bf16x8 b0=*reinterpret_cast<const bf16x8*>(kb+d0*2048);
    const bf16x8 b1=*reinterpret_cast<const bf16x8*>(kb+d0*2048+512);
    if(d0==0){p0=__builtin_amdgcn_mfma_f32_32x32x16_bf16(b0,qr[0],negm,0,0,0);p1=__builtin_amdgcn_mfma_f32_32x32x16_bf16(b1,qr[0],negm,0,0,0);}
    else{p0=__builtin_amdgcn_mfma_f32_32x32x16_bf16(b0,qr[d0],p0,0,0,0);p1=__builtin_amdgcn_mfma_f32_32x32x16_bf16(b1,qr[d0],p1,0,0,0);}}
}
typedef __attribute__((address_space(3))) const char* lds_cptr;
typedef short v4i16_t __attribute__((ext_vector_type(4)));
__device__ __forceinline__ void kload8(bf16x8*kf,lds_cptr kp){
  kf[0]=*(const __attribute__((address_space(3))) bf16x8*)(kp);      kf[1]=*(const __attribute__((address_space(3))) bf16x8*)(kp+512);
  kf[2]=*(const __attribute__((address_space(3))) bf16x8*)(kp+2048); kf[3]=*(const __attribute__((address_space(3))) bf16x8*)(kp+2560);
  kf[4]=*(const __attribute__((address_space(3))) bf16x8*)(kp+4096); kf[5]=*(const __attribute__((address_space(3))) bf16x8*)(kp+4608);
  kf[6]=*(const __attribute__((address_space(3))) bf16x8*)(kp+6144); kf[7]=*(const __attribute__((address_space(3))) bf16x8*)(kp+6656);
}
__device__ __forceinline__ void kload2(bf16x8*kf,lds_cptr kp,int j){ kf[2*j]=*(const __attribute__((address_space(3))) bf16x8*)(kp+j*2048); kf[2*j+1]=*(const __attribute__((address_space(3))) bf16x8*)(kp+j*2048+512); }
__device__ __forceinline__ s16x4 vtr(lds_cptr p){ return __builtin_bit_cast(s16x4,__builtin_amdgcn_ds_read_tr16_b64_v4i16((__attribute__((address_space(3))) v4i16_t*)p)); }
__device__ __forceinline__ float rowmax(const f32x16&p0,const f32x16&p1){
  float a=max3f(p0[0],p0[1],p1[0]),b=max3f(p0[2],p0[3],p1[1]);a=max3f(a,p1[2],p1[3]);
  #pragma unroll
  for(int r=4;r<16;r+=4){a=max3f(a,p0[r],p0[r+1]);b=max3f(b,p0[r+2],p0[r+3]);a=max3f(a,p1[r],p1[r+1]);b=max3f(b,p1[r+2],p1[r+3]);}
  const float m=max2f(a,b);
  auto rr=__builtin_amdgcn_permlane32_swap(__float_as_uint(m),__float_as_uint(m),false,false);
  return max2f(__uint_as_float(rr[0]),__uint_as_float(rr[1]));
}
__device__ __forceinline__ void pv(f32x16*o,int vb,bf16x8 pa0,bf16x8 pa1,bf16x8 pa2,bf16x8 pa3){
  #pragma unroll
  for(int d0=0;d0<2;++d0){s16x4 lo[4],hi[4];
    #pragma unroll
    for(int ks=0;ks<4;++ks){
      asm volatile("ds_read_b64_tr_b16 %0,%1 offset:%c2":"=&v"(lo[ks]):"v"(vb),"i"(d0*4096+ks*1024):"memory");
      asm volatile("ds_read_b64_tr_b16 %0,%1 offset:%c2":"=&v"(hi[ks]):"v"(vb),"i"(d0*4096+ks*1024+512):"memory");}
    asm volatile("s_waitcnt lgkmcnt(0)":::"memory");SBAR();
    #define PK(k) (bf16x8){lo[k][0],lo[k][1],lo[k][2],lo[k][3],hi[k][0],hi[k][1],hi[k][2],hi[k][3]}
    o[d0]=__builtin_amdgcn_mfma_f32_32x32x16_bf16(pa0,PK(0),o[d0],0,0,0);
    o[d0]=__builtin_amdgcn_mfma_f32_32x32x16_bf16(pa1,PK(1),o[d0],0,0,0);
    o[d0]=__builtin_amdgcn_mfma_f32_32x32x16_bf16(pa2,PK(2),o[d0],0,0,0);
    o[d0]=__builtin_amdgcn_mfma_f32_32x32x16_bf16(pa3,PK(3),o[d0],0,0,0);
    #undef PK
  }
}
#ifndef ATTN_STORE16
#define ATTN_STORE16(p,v) (*(u32x4*)(p)=(v))
#endif
template<int THRL> __device__ __forceinline__ void attn_unit(int b,int h,int qb,const bf16*Q,const bf16*__restrict__ K,const bf16*__restrict__ V,bf16*O,char*shm){
  const int tid=threadIdx.x,lane=tid&63,r32=lane&31,hi=lane>>5; const int wid=__builtin_amdgcn_readfirstlane(tid>>6);
  const long rowbase=(long)b*SEQ; const int q0=qb*QB;
  const bf16*Qw=Q+(rowbase+q0+wid*QBLK)*DM+h*D;
  const bf16*Kh=K+rowbase*DM+h*D,*Vh=V+rowbase*DM+h*D;
  const unsigned lds0=(unsigned)(uintptr_t)shm;
  float*wsf=(float*)(shm+LDS_WS)+wid*64;
  const bf16*ksrc=Kh+(long)lane*DM+wid*8;
  const bf16*vsrc=Vh+(long)(16*(wid&3)+(lane>>2))*DM+(wid>>2)*32+(lane&3)*8;
  const unsigned kdst=lds0+LDS_K+wid*1024, vdst=lds0+LDS_V+wid*1024;
  const int NT=(q0+QB)/KVBLK;
  #define TMAP(t) (((t)<4)?(NT-4+(t)):((t)-4))
  #define DMA_K(t,slot) glds16(ksrc+(long)TMAP(t)*KVBLK*DM,(unsigned)__builtin_amdgcn_readfirstlane(kdst+(slot)))
  #define DMA_V(t,slot) glds16(vsrc+(long)TMAP(t)*KVBLK*DM,(unsigned)__builtin_amdgcn_readfirstlane(vdst+(slot)))
  const int vb0=(int)(lds0+LDS_V)+((lane>>4)&1)*32+(lane&3)*8+(4*hi+((lane&15)>>2))*64;
  const char*Kbase=shm+LDS_K; bf16x8 kf[8];
  const lds_cptr shm3=(lds_cptr)shm; const lds_cptr kp0=shm3+LDS_K+hi*1024+r32*16; const lds_cptr vp0=shm3+LDS_V+((lane>>4)&1)*32+(lane&3)*8+(4*hi+((lane&15)>>2))*64;
  DMA_K(0,0);DMA_V(0,0);DMA_K(1,SLOTB);
  bf16x8 qr[4];
  #pragma unroll
  for(int d0=0;d0<4;++d0)qr[d0]=*reinterpret_cast<const bf16x8*>(&Qw[(long)r32*DM+d0*16+hi*8]);
  unsigned selbits=0u;
  { const __attribute__((address_space(3))) float*km=(const __attribute__((address_space(3))) float*)((lds_cptr)shm+LDS_KMEAN); float g[7];
    #pragma unroll
    for(int j=0;j<7;++j){ float s=-INFINITY;
      if(j<qb){ s=0.f;
        #pragma unroll
        for(int d0=0;d0<4;++d0){ const __attribute__((address_space(3))) float*kp=km+j*64+d0*16+hi*8;
          #pragma unroll
          for(int e=0;e<8;++e) s+=__uint_as_float(((unsigned)(unsigned short)qr[d0][e])<<16)*kp[e]; }
        auto rr=__builtin_amdgcn_permlane32_swap(__float_as_uint(s),__float_as_uint(s),false,false);
        s=__uint_as_float(rr[0])+__uint_as_float(rr[1]); }
      g[j]=s; }
    #pragma unroll
    for(int pass=0;pass<3;++pass){ float best=-INFINITY; int bi=-1;
      #pragma unroll
      for(int j=0;j<7;++j){ const bool ok=(j<qb)&&!((selbits>>j)&1u)&&(g[j]>best); if(ok){best=g[j];bi=j;} }
      if(bi>=0)selbits|=(1u<<bi); }
  }
  float mhat=0.f,l_reg=0.f;f32x16 o[2];o[0]=f32x16{};o[1]=f32x16{};
  const int qrel=wid*QBLK+r32;
  #define CMASK(P0,P1,t) do{ const int t_=(t); if(t_<4){cmask(P0,P1,t_,qrel,hi);} else { if(!((selbits>>(((t_-4)>>2)&7))&1u)) allmask(P0,P1); } }while(0)
  bool resc=false;
  #define START(P0,P1) do{ const float rm=rowmax(P0,P1); resc=false; \
    { const float dl=rm; mhat=fadd_s(mhat,dl); \
      _Pragma("unroll") for(int r=0;r<16;++r){P0[r]=fsub_s(P0[r],dl);P1[r]=fsub_s(P1[r],dl);} \
      } \
    _Pragma("unroll") for(int r=0;r<16;++r)P0[r]=__builtin_amdgcn_exp2f(P0[r]); }while(0)
  #define RESC() do{ if(resc){ asm volatile("s_waitcnt lgkmcnt(0)":::"memory"); \
      _Pragma("unroll") for(int d_=0;d_<2;++d_) _Pragma("unroll") for(int r=0;r<16;++r)o[d_][r]*=wsf[crow(r,hi)]; } }while(0)
  f32x16 pA0,pA1,pB0,pB1;
  int sl_prev=0,sl_cur=0,sl_next=SLOTB;
  #define ROT() do{sl_prev=sl_cur;sl_cur=sl_next;sl_next=(sl_next==(NSLOT-1)*SLOTB)?0:sl_next+SLOTB;}while(0)
  DMA_K(2,2*SLOTB);
  WAIT_BAR(3);
  qkt(pA0,pA1,Kbase,qr,r32,hi);asm volatile("s_nop 15\n\ts_nop 7":"+v"(pA0),"+v"(pA1));CMASK(pA0,pA1,0);
  START(pA0,pA1);
  _Pragma("unroll") for(int r=0;r<16;++r)pA1[r]=__builtin_amdgcn_exp2f(pA1[r]);
  WAIT_BAR(0);
  DMA_K(3,0);DMA_V(1,SLOTB);
  ROT();
  kload8(kf,kp0+sl_cur);
  WAIT_BAR(2);
  s16x4 vlo[8],vhi[8]; u32x4 pw0,pw1,pw2,pw3;
  #define PKW(P,B) cvtpk_s(P[B],P[B+1])
  #define PAF(k) __builtin_bit_cast(bf16x8,pw##k)
  #define VFR(i) (bf16x8){vlo[i][0],vlo[i][1],vlo[i][2],vlo[i][3],vhi[i][0],vhi[i][1],vhi[i][2],vhi[i][3]}
  #define PIN(x) asm volatile("":"+v"(x))
  #define MX3(a,b,c) __builtin_fmaxf(__builtin_fmaxf((a),(b)),(c))
  #define GAPA(MF,A0,A1,A2,A3,W0,W1,PW) do{ MF; sacc+=A0; sacc+=A1; sacc+=A2; sacc+=A3; PIN(sacc); W0; W1; PIN(PW); SBAR(); }while(0)
  #define EX(v) __builtin_amdgcn_exp2f(v)
  #define GAPB(MF,X,B) do{ MF; X[B]=EX(X[B]); X[B+1]=EX(X[B+1]); X[B+2]=EX(X[B+2]); X[B+3]=EX(X[B+3]); PIN(X); SBAR(); }while(0)
  #define VRD(i) do{ vlo[i]=vtr(vp_+(((i)>>2)*4096+((i)&3)*1024)); vhi[i]=vtr(vp_+(((i)>>2)*4096+((i)&3)*1024+512)); }while(0)
  #define KRD(G,j) do{ if(G){ kload2(kf,kp0+sl_next,j); SBAR(); } }while(0)
  #define STEP(C0,C1,P0,P1,t,GK,GV,GL) do{ SBAR(); \
    const lds_cptr vp_=vp0+sl_prev; \
    VRD(0); SBAR(); float sacc=(P0[0]+P0[1]); \
    GAPA(C0=__builtin_amdgcn_mfma_f32_32x32x16_bf16(kf[0],qr[0],f32x16{},0,0,0), P0[2],P0[3],P0[4],P0[5],     pw0[0]=PKW(P0,0), pw0[1]=PKW(P0,2), pw0); \
    VRD(4); SBAR(); GAPA(C1=__builtin_amdgcn_mfma_f32_32x32x16_bf16(kf[1],qr[0],f32x16{},0,0,0), P0[6],P0[7],P0[8],P0[9],     pw0[2]=PKW(P0,4), pw0[3]=PKW(P0,6), pw0); \
    VRD(1); SBAR(); GAPA(C0=__builtin_amdgcn_mfma_f32_32x32x16_bf16(kf[2],qr[1],C0,0,0,0),   P0[10],P0[11],P0[12],P0[13], pw1[0]=PKW(P0,8), pw1[1]=PKW(P0,10), pw1); \
    VRD(5); SBAR(); GAPA(C1=__builtin_amdgcn_mfma_f32_32x32x16_bf16(kf[3],qr[1],C1,0,0,0),   P0[14],P0[15],P1[0],P1[1],   pw1[2]=PKW(P0,12),pw1[3]=PKW(P0,14), pw1); \
    VRD(2); SBAR(); GAPA(C0=__builtin_amdgcn_mfma_f32_32x32x16_bf16(kf[4],qr[2],C0,0,0,0),   P1[2],P1[3],P1[4],P1[5],     pw2[0]=PKW(P1,0), pw2[1]=PKW(P1,2), pw2); \
    VRD(6); SBAR(); GAPA(C1=__builtin_amdgcn_mfma_f32_32x32x16_bf16(kf[5],qr[2],C1,0,0,0),   P1[6],P1[7],P1[8],P1[9],     pw2[2]=PKW(P1,4), pw2[3]=PKW(P1,6), pw2); \
    VRD(3); SBAR(); GAPA(C0=__builtin_amdgcn_mfma_f32_32x32x16_bf16(kf[6],qr[3],C0,0,0,0),   P1[10],P1[11],P1[12],P1[13], pw3[0]=PKW(P1,8), pw3[1]=PKW(P1,10), pw3); \
    VRD(7); SBAR(); GAPA(C1=__builtin_amdgcn_mfma_f32_32x32x16_bf16(kf[7],qr[3],C1,0,0,0),   P1[14],P1[15],0.f,0.f,       pw3[2]=PKW(P1,12),pw3[3]=PKW(P1,14), pw3); \
    l_reg+=sacc; \
    if(GK){DMA_K((t)+3,sl_cur);} if(GV){DMA_V((t)+1,sl_next);} \
    CMASK(C0,C1,t); \
    _Pragma("unroll") for(int r=0;r<16;++r){C0[r]-=mhat;C1[r]-=mhat;} \
    { float a=MX3(C0[0],C0[1],C1[0]),b=MX3(C0[2],C0[3],C1[1]); a=MX3(a,C1[2],C1[3]); \
      _Pragma("unroll") for(int r=4;r<16;r+=4){a=MX3(a,C0[r],C0[r+1]);b=MX3(b,C0[r+2],C0[r+3]);a=MX3(a,C1[r],C1[r+1]);b=MX3(b,C1[r+2],C1[r+3]);} \
      float rm=__builtin_fmaxf(a,b); { auto rr=__builtin_amdgcn_permlane32_swap(__float_as_uint(rm),__float_as_uint(rm),false,false); rm=__builtin_fmaxf(__uint_as_float(rr[0]),__uint_as_float(rr[1])); } \
      resc=false; \
      if(__builtin_expect(__any(rm>(float)THRL),0)){ const float dl=__builtin_fmaxf(rm,0.f); mhat+=dl; \
        _Pragma("unroll") for(int r=0;r<16;++r){C0[r]-=dl;C1[r]-=dl;} \
        const float f=__builtin_amdgcn_exp2f(-dl); l_reg*=f; if(hi==0)wsf[r32]=f; resc=true; } } \
    SBAR(); \
    GAPB(o[0]=__builtin_amdgcn_mfma_f32_32x32x16_bf16(PAF(0),VFR(0),o[0],0,0,0), C0,0); \
    GAPB(o[1]=__builtin_amdgcn_mfma_f32_32x32x16_bf16(PAF(0),VFR(4),o[1],0,0,0), C0,4); \
    KRD(GL,0); GAPB(o[0]=__builtin_amdgcn_mfma_f32_32x32x16_bf16(PAF(1),VFR(1),o[0],0,0,0), C0,8); \
    KRD(GL,1); GAPB(o[1]=__builtin_amdgcn_mfma_f32_32x32x16_bf16(PAF(1),VFR(5),o[1],0,0,0), C0,12); \
    KRD(GL,2); GAPB(o[0]=__builtin_amdgcn_mfma_f32_32x32x16_bf16(PAF(2),VFR(2),o[0],0,0,0), C1,0); \
    KRD(GL,3); GAPB(o[1]=__builtin_amdgcn_mfma_f32_32x32x16_bf16(PAF(2),VFR(6),o[1],0,0,0), C1,4); \
    GAPB(o[0]=__builtin_amdgcn_mfma_f32_32x32x16_bf16(PAF(3),VFR(3),o[0],0,0,0), C1,8); \
    GAPB(o[1]=__builtin_amdgcn_mfma_f32_32x32x16_bf16(PAF(3),VFR(7),o[1],0,0,0), C1,12); \
    }while(0)
  int t=1;
  for(;t+5<NT;t+=2){
    STEP(pB0,pB1,pA0,pA1,t,true,true,true);     WAIT_BAR(2); RESC(); ROT();
    STEP(pA0,pA1,pB0,pB1,t+1,true,true,true);   WAIT_BAR(2); RESC(); ROT();
  }
  #define ENDW(tt) do{ if((tt)+3<NT){WAIT_BAR(2);} else if((tt)+2<NT){WAIT_BAR(1);} else {WAIT_BAR(0);} }while(0)
  for(;t+1<NT;t+=2){
    STEP(pB0,pB1,pA0,pA1,t,(t+3<NT),(t+1<NT),(t+1<NT));       ENDW(t);   RESC(); ROT();
    STEP(pA0,pA1,pB0,pB1,t+1,(t+4<NT),(t+2<NT),(t+2<NT));     ENDW(t+1); RESC(); ROT();
  }
  STEP(pB0,pB1,pA0,pA1,NT-1,false,false,false); RESC();
  { float sacc=pB0[0]+pB0[1]; _Pragma("unroll") for(int r=2;r<16;++r)sacc+=pB0[r]; _Pragma("unroll") for(int r=0;r<16;++r)sacc+=pB1[r]; l_reg+=sacc;
    pw0=(u32x4){PKW(pB0,0),PKW(pB0,2),PKW(pB0,4),PKW(pB0,6)};pw1=(u32x4){PKW(pB0,8),PKW(pB0,10),PKW(pB0,12),PKW(pB0,14)};pw2=(u32x4){PKW(pB1,0),PKW(pB1,2),PKW(pB1,4),PKW(pB1,6)};pw3=(u32x4){PKW(pB1,8),PKW(pB1,10),PKW(pB1,12),PKW(pB1,14)};
    SBAR(); pv(o,vb0+sl_cur,PAF(0),PAF(1),PAF(2),PAF(3)); }
  #undef PKW
  #undef PAF
  #undef VFR
  #undef PIN
  #undef MX3
  #undef GAPA
  #undef GAPB
  #undef EX
  #undef VRD
  #undef KRD
  #undef STEP
  #undef ENDW
  {auto rr=__builtin_amdgcn_permlane32_swap(__float_as_uint(l_reg),__float_as_uint(l_reg),false,false);l_reg=__uint_as_float(rr[0])+__uint_as_float(rr[1]);}
  if(hi==0)wsf[32+r32]=l_reg;asm volatile("s_waitcnt lgkmcnt(0)":::"memory");
  float rli[16];
  #pragma unroll
  for(int r=0;r<16;++r)rli[r]=__builtin_amdgcn_rcpf(wsf[32+crow(r,hi)]);
  bf16*Ow=O+(rowbase+q0+wid*QBLK)*DM+h*D;
  { bf16*stg=(bf16*)(shm+LDS_OST)+wid*2048;
    #pragma unroll
    for(int r=0;r<16;++r){const int orow=crow(r,hi);
      #pragma unroll
      for(int d0=0;d0<2;++d0)stg[orow*64+d0*32+r32]=__float2bfloat16(o[d0][r]*rli[r]);}
    asm volatile("s_waitcnt lgkmcnt(0)":::"memory");
    #pragma unroll
    for(int i=0;i<4;++i){const int row=i*8+(lane>>3),ch=lane&7; const u32x4 v=*(const u32x4*)(stg+row*64+ch*8); ATTN_STORE16(Ow+(long)row*DM+ch*8,v);} }
  asm volatile("s_waitcnt lgkmcnt(0)\n\ts_barrier":::"memory");
  #undef DMA_K
  #undef DMA_V
  #undef TMAP
  #undef CMASK
  #undef START
  #undef RESC
  #undef ROT
}
#undef SBAR
#undef WAIT_BAR
}

struct Args { const void* in[36]; float* out; unsigned char* ws; int ph_lo, ph_hi; };
typedef __attribute__((address_space(4))) const unsigned char* kptr_t;
__device__ __forceinline__ const void* inp_ptr(int k) {
    kptr_t base = (kptr_t)__builtin_amdgcn_kernarg_segment_ptr();
    asm volatile("" : "+s"(base));
    return *(const void* const __attribute__((address_space(4)))*)(base + 8 * k);
}
#define INP(k) inp_ptr(k)
struct Frame {
    LAS unsigned char* lds;
    int tid, lane, wave, vcu, G;
    unsigned char* ws;
};

__device__ __forceinline__ int rowmap(int kind, int n) {
    if (kind == 1) return (n & ~31) + pg8::invperm32(n & 31);
    if (kind == 2) { const int c = n & 255; return (n & ~255) + 128 * ((c >> 5) & 1) + 32 * (c >> 6) + 16 * ((c >> 2) & 1) + 4 * ((c >> 3) & 3) + (c & 3); }
    if (kind == 3) { const int pn = n >> 7, q = n & 127; return pn * 256 + (q & ~31) + pg8::invperm32(q & 31); }
    if (kind == 4) { const int j = n & 255; return (n & ~255) + 128 * ((j >> 3) & 1) + 32 * (j >> 6) + 16 * ((j >> 2) & 1) + 4 * ((j >> 4) & 3) + (j & 3); }
    return n;
}
__device__ __forceinline__ void conv_item(const float* W, int Nsrc, int k0, int n0, bf16* WT, int dst_ld, int dst_k0, int row_off, int kind, int smode, const float* sv, bool zero, LAS float* scr, int lane) {
    if (!zero) {
        const int rr = lane >> 3, c4 = (lane & 7) * 4;
        f32x4 w[8];
#pragma unroll
        for (int i = 0; i < 8; ++i) w[i] = *(const f32x4*)(W + (size_t)(k0 + 8 * i + rr) * Nsrc + n0 + c4);
#pragma unroll
        for (int i = 0; i < 8; ++i) { const int kk = 8 * i + rr; f32x4 v = w[i];
            if (smode == 1) v = v * sv[k0 + kk]; else if (smode == 2) v = v * (1.0f - sv[k0 + kk]);
            *(LAS f32x4*)(scr + kk * 32 + (c4 ^ (4 * i))) = v; }
    }
    LDS_WAIT(); asm volatile("" ::: "memory");
    const int c = lane & 7;
#pragma unroll
    for (int j = 0; j < 4; ++j) { const int n = (lane >> 3) + 8 * j; const LAS float* s = scr + (8 * c) * 32 + (n ^ (4 * c));
        v4u o; if (zero) o = (v4u){0u, 0u, 0u, 0u}; else { o.x = pk2(s[0 * 32], s[1 * 32]); o.y = pk2(s[2 * 32], s[3 * 32]); o.z = pk2(s[4 * 32], s[5 * 32]); o.w = pk2(s[6 * 32], s[7 * 32]); }
        *(v4u*)(WT + (size_t)(row_off + rowmap(kind, n0 + n)) * dst_ld + dst_k0 + k0 + 8 * c) = o; }
    LDS_WAIT(); asm volatile("" ::: "memory");
}
__device__ __forceinline__ void conv_mat(int& cursor, int gw, int NGW, const float* W, int K, int N, int Nsrc, bf16* WT, int dst_ld, int dst_k0, int row_off, int kind, int smode, const float* sv, LAS float* scr, int lane) {
    const int nblk = N / 32, ni = (K / 64) * nblk;
    const int first = cursor + (((gw - cursor) % NGW) + NGW) % NGW;
    for (int it = first; it < cursor + ni; it += NGW) { const int li = it - cursor, kb = li / nblk, nb = li % nblk;
        conv_item(W, Nsrc, 64 * kb, 32 * nb, WT, dst_ld, dst_k0, row_off, kind, smode, sv, false, scr, lane); }
    cursor += ni;
}

__device__ __forceinline__ float row_load_rinv(const float* xrow, int lane, f32x4 (&v)[4]) {
    const f32x4* xr = (const f32x4*)xrow + lane; float s = 0.f;
#pragma unroll
    for (int j = 0; j < 4; ++j) { v[j] = xr[64 * j]; s += (v[j][0] * v[j][0] + v[j][1] * v[j][1]) + (v[j][2] * v[j][2] + v[j][3] * v[j][3]); }
    return __builtin_amdgcn_rsqf(wave_sum(s) * (1.0f / DM) + RMS_EPS);
}
__device__ __forceinline__ void row_store_bf16(bf16* orow, int lane, const f32x4 (&v)[4]) {
    unsigned long long* o8 = (unsigned long long*)orow + lane;
#pragma unroll
    for (int j = 0; j < 4; ++j) o8[64 * j] = (unsigned long long)pk2(v[j][0], v[j][1]) | ((unsigned long long)pk2(v[j][2], v[j][3]) << 32);
}
__device__ __forceinline__ void load_vec(const float* p, int lane, f32x4 (&v)[4]) {
#pragma unroll
    for (int j = 0; j < 4; ++j) v[j] = ((const f32x4*)p + lane)[64 * j];
}

__device__ __forceinline__ void p0_prologue(Frame& F, const Args& a) {
    unsigned char* ws = F.ws;
    LAS float* scr = (LAS float*)(F.lds + F.wave * 16384);
    const int gw = F.vcu * NWAVES + F.wave, NGW = F.G * NWAVES, lane = F.lane;
    const float* mu = (const float*)INP(7);
    f32x4 e_q[4], e_m0[4], e_m1[4];
    load_vec((const float*)INP(25) + (size_t)gw * DM, lane, e_q);
    load_vec((const float*)INP(1) + (size_t)gw * DM, lane, e_m0);
    load_vec((const float*)INP(1) + (size_t)(gw + NGW) * DM, lane, e_m1);
    {
        int cur = 0;
        const float* wrkv = (const float*)INP(19);
        bf16* WRKV = (bf16*)(ws + WS_WRKV); bf16* WLD = (bf16*)(ws + WS_WLD); bf16* WLU = (bf16*)(ws + WS_WLU);
        conv_mat(cur, gw, NGW, wrkv, DM, DM, DM, WRKV, DM, 0, 0, 1, 0, nullptr, scr, lane);
        conv_mat(cur, gw, NGW, wrkv + (size_t)DM * DM, DM, DM, DM, WRKV, DM, 0, DM, 1, 0, nullptr, scr, lane);
        conv_mat(cur, gw, NGW, wrkv + (size_t)2 * DM * DM, DM, DM, DM, WRKV, DM, 0, 2 * DM, 1, 0, nullptr, scr, lane);
        conv_mat(cur, gw, NGW, (const float*)INP(22), DM, DM, DM, (bf16*)(ws + WS_WRWO), DM, 0, 0, 1, 0, nullptr, scr, lane);
        conv_mat(cur, gw, NGW, (const float*)INP(9), DM, 64, 64, WLD, 2048, 0, 0, 1, 2, mu + 1 * DM, scr, lane);
        conv_mat(cur, gw, NGW, (const float*)INP(9), DM, 64, 64, WLD, 2048, 1024, 0, 1, 1, mu + 1 * DM, scr, lane);
        conv_mat(cur, gw, NGW, (const float*)INP(12), DM, 64, 64, WLD, 2048, 0, 64, 1, 2, mu + 4 * DM, scr, lane);
        conv_mat(cur, gw, NGW, (const float*)INP(12), DM, 64, 64, WLD, 2048, 1024, 64, 1, 1, mu + 4 * DM, scr, lane);
        conv_mat(cur, gw, NGW, (const float*)INP(14), DM, 128, 128, WLD, 2048, 0, 128, 1, 2, mu + 5 * DM, scr, lane);
        conv_mat(cur, gw, NGW, (const float*)INP(14), DM, 128, 128, WLD, 2048, 1024, 128, 1, 1, mu + 5 * DM, scr, lane);
        conv_mat(cur, gw, NGW, (const float*)INP(10), 64, DM, DM, WLU, 256, 0, 0, 1, 0, nullptr, scr, lane);
        conv_mat(cur, gw, NGW, (const float*)INP(13), 64, DM, DM, WLU, 256, 64, DM, 1, 0, nullptr, scr, lane);
        conv_mat(cur, gw, NGW, (const float*)INP(15), 128, DM, DM, WLU, 256, 128, 2 * DM, 1, 0, nullptr, scr, lane);
        {
            const int zfirst = cur + (((gw - cur) % NGW) + NGW) % NGW, nz = 3 * 32 * 4;
            for (int it = zfirst; it < cur + nz; it += NGW) { const int li = it - cur, kb = li & 3, nb = (li >> 2) & 31, rg = li >> 7;
                const bool has = (rg == 0 && kb == 0) || (rg == 1 && kb == 1) || (rg == 2 && kb >= 2);
                if (!has) conv_item(nullptr, 0, 64 * kb, 32 * nb, WLU, 256, 0, rg * DM, 0, 0, nullptr, true, scr, lane); }
            cur += nz;
        }
        conv_mat(cur, gw, NGW, (const float*)INP(23), DM, 2 * DM, 3 * DM, (bf16*)(ws + WS_WMBQKV), DM, 0, 0, 2, 1, (const float*)INP(3) + DM, scr, lane);
        conv_mat(cur, gw, NGW, (const float*)INP(23) + 2 * DM, DM, DM, 3 * DM, (bf16*)(ws + WS_WMBQKV), DM, 0, 2 * DM, 1, 1, (const float*)INP(3) + DM, scr, lane);
        conv_mat(cur, gw, NGW, (const float*)INP(24), DM, DM, DM, (bf16*)(ws + WS_WMBO), DM, 0, 0, 1, 0, nullptr, scr, lane);
#pragma unroll
        for (int l = 0; l < 2; ++l) {
            conv_mat(cur, gw, NGW, (const float*)INP(26) + (size_t)l * DM * 2 * DM, DM, DM, 2 * DM, (bf16*)(ws + WS_WMXK) + (size_t)l * DM * DM, DM, 0, 0, 1, 0, nullptr, scr, lane);
            conv_mat(cur, gw, NGW, (const float*)INP(26) + (size_t)l * DM * 2 * DM + DM, DM, DM, 2 * DM, (bf16*)(ws + WS_WMXV) + (size_t)l * DM * DM, DM, 0, 0, 1, 0, nullptr, scr, lane);
            conv_mat(cur, gw, NGW, (const float*)INP(27) + (size_t)l * DM * DM, DM, DM, DM, (bf16*)(ws + WS_WMXO) + (size_t)l * DM * DM, DM, 0, 0, 1, 0, nullptr, scr, lane);
        }
    }
    {
        const int r = gw, l = r >> 10, k = r & 1023;
        const float gk = ((const float*)INP(4))[l * DM + k];
#pragma unroll
        for (int j = 0; j < 4; ++j) e_q[j] = e_q[j] * gk;
        row_store_bf16((bf16*)(ws + WS_WMXQ) + (size_t)r * DM, lane, e_q);
    }
    {
        const float* g = (const float*)INP(5);
        f32x4 g0[4], g1[4]; load_vec(g, lane, g0); load_vec(g + DM, lane, g1);
#define P0_MEMROW(V, r_) do { float sq = 0.f; \
            _Pragma("unroll") for (int j = 0; j < 4; ++j) sq += (V[j][0] * V[j][0] + V[j][1] * V[j][1]) + (V[j][2] * V[j][2] + V[j][3] * V[j][3]); \
            const float ri = __builtin_amdgcn_rsqf(wave_sum(sq) * (1.0f / DM) + RMS_EPS); f32x4 o[4]; \
            _Pragma("unroll") for (int j = 0; j < 4; ++j) o[j] = V[j] * ri * g0[j]; \
            row_store_bf16((bf16*)(ws + WS_MEMN) + (size_t)(r_) * DM, lane, o); \
            _Pragma("unroll") for (int j = 0; j < 4; ++j) o[j] = V[j] * ri * g1[j]; \
            row_store_bf16((bf16*)(ws + WS_MEMN) + (size_t)(NMEM + (r_)) * DM, lane, o); } while (0)
        P0_MEMROW(e_m0, gw); P0_MEMROW(e_m1, gw + NGW);
#undef P0_MEMROW
    }
    {
        const int* pos = (const int*)INP(2); f32x2* tab = (f32x2*)(ws + WS_ROPE);
        const float inv = powf(10000.0f, -(float)(lane & 31) * 2.0f / 64.0f);
        for (int i = gw * 64 + lane; i < NTOK * 32; i += NGW * 64) { const int row = i >> 5;
            const float ang = (float)pos[row] * inv; float sn, cs; sincosf(ang, &sn, &cs);
            tab[i] = (f32x2){cs, sn}; }
    }
    {
        const float* x = (const float*)INP(0); const float* g = (const float*)INP(3);
        bf16* XR = (bf16*)(ws + ARENA(0)); bf16* XK = (bf16*)(ws + ARENA(1)); bf16* XV = (bf16*)(ws + ARENA(2)); bf16* HP = (bf16*)(ws + ARENA(6));
        f32x4 gv[4], mr[4], mk[4], mv[4]; load_vec(g, lane, gv); load_vec(mu + 0 * DM, lane, mr); load_vec(mu + 2 * DM, lane, mk); load_vec(mu + 3 * DM, lane, mv);
        for (int ch = gw; ch < NTOK / 16; ch += NGW) {
            const int r0 = ch * 16, b = r0 / SEQ, t0 = r0 % SEQ;
            f32x4 prev[4];
            if (t0 == 0) {
#pragma unroll
                for (int j = 0; j < 4; ++j) prev[j] = (f32x4){0.f, 0.f, 0.f, 0.f};
                row_store_bf16(HP + (size_t)b * (SEQ + 1) * DM, lane, prev);
            } else { f32x4 v[4]; const float ri = row_load_rinv(x + (size_t)(r0 - 1) * DM, lane, v);
#pragma unroll
                for (int j = 0; j < 4; ++j) prev[j] = v[j] * ri * gv[j]; }
            f32x4 nv[4], nw[4], nz[4]; load_vec(x + (size_t)r0 * DM, lane, nv); load_vec(x + (size_t)(r0 + 1) * DM, lane, nw); load_vec(x + (size_t)(r0 + 2) * DM, lane, nz);
#define P0_ROW(BUF, i_) do { const int r = r0 + (i_); f32x4 v[4], h[4], o[4]; float sq = 0.f; \
                _Pragma("unroll") for (int j = 0; j < 4; ++j) { v[j] = BUF[j]; sq += (v[j][0] * v[j][0] + v[j][1] * v[j][1]) + (v[j][2] * v[j][2] + v[j][3] * v[j][3]); } \
                if ((i_) + 3 < 16) load_vec(x + (size_t)(r + 3) * DM, lane, BUF); \
                const float ri = __builtin_amdgcn_rsqf(wave_sum(sq) * (1.0f / DM) + RMS_EPS); \
                _Pragma("unroll") for (int j = 0; j < 4; ++j) h[j] = v[j] * ri * gv[j]; \
                row_store_bf16(HP + ((size_t)b * (SEQ + 1) + 1 + t0 + (i_)) * DM, lane, h); \
                _Pragma("unroll") for (int j = 0; j < 4; ++j) o[j] = h[j] + (prev[j] - h[j]) * mr[j]; \
                row_store_bf16(XR + (size_t)r * DM, lane, o); \
                _Pragma("unroll") for (int j = 0; j < 4; ++j) o[j] = h[j] + (prev[j] - h[j]) * mk[j]; \
                row_store_bf16(XK + (size_t)r * DM, lane, o); \
                _Pragma("unroll") for (int j = 0; j < 4; ++j) o[j] = h[j] + (prev[j] - h[j]) * mv[j]; \
                row_store_bf16(XV + (size_t)r * DM, lane, o); \
                _Pragma("unroll") for (int j = 0; j < 4; ++j) prev[j] = h[j]; } while (0)
            for (int i = 0; i < 15; i += 3) { P0_ROW(nv, i); P0_ROW(nw, i + 1); P0_ROW(nz, i + 2); }
            P0_ROW(nv, 15);
#undef P0_ROW
        }
    }
}

__device__ __forceinline__ void norm_rows(Frame& F, const float* X, const float* g, bf16* out) {
    const int gw = F.vcu * NWAVES + F.wave, NGW = F.G * NWAVES, lane = F.lane;
    f32x4 gv[4]; load_vec(g, lane, gv);
    for (int r = gw; r < NTOK; r += NGW) { f32x4 v[4]; const float ri = row_load_rinv(X + (size_t)r * DM, lane, v);
#pragma unroll
        for (int j = 0; j < 4; ++j) v[j] = v[j] * ri * gv[j];
        row_store_bf16(out + (size_t)r * DM, lane, v); }
}
__device__ __forceinline__ void combine_rows(Frame& F, bf16* X, const unsigned char* Y, const float* g, float* RN, float* OUT, bool final) {
    const int gw = F.vcu * NWAVES + F.wave, NGW = F.G * NWAVES, lane = F.lane;
    f32x4 gv[4]; load_vec(g, lane, gv);
    unsigned long long xa[4], xb[4]; unsigned ya0[4], ya1[4], yb0[4], yb1[4];
#define CB_LOAD(XB, Y0B, Y1B, r_) do { const unsigned long long* xr = (const unsigned long long*)(X + (size_t)(r_) * DM) + lane; \
        const unsigned* y0 = (const unsigned*)(Y + (size_t)(2 * (r_)) * DM) + lane; const unsigned* y1 = (const unsigned*)(Y + (size_t)(2 * (r_) + 1) * DM) + lane; \
        _Pragma("unroll") for (int j = 0; j < 4; ++j) { XB[j] = xr[64 * j]; Y0B[j] = y0[64 * j]; Y1B[j] = y1[64 * j]; } } while (0)
#define CB_ROW(XB, Y0B, Y1B, r_) do { f32x4 v[4]; float s = 0.f; \
        _Pragma("unroll") for (int j = 0; j < 4; ++j) { const unsigned long long x = XB[j]; const int a = (int)Y0B[j], b = (int)Y1B[j]; \
            v[j][0] = bflo((unsigned)x) + (__builtin_amdgcn_cvt_f32_fp8(a, 0) + __builtin_amdgcn_cvt_f32_fp8(b, 0)) * (1.0f / Y_SCALE); \
            v[j][1] = bfhi((unsigned)x) + (__builtin_amdgcn_cvt_f32_fp8(a, 1) + __builtin_amdgcn_cvt_f32_fp8(b, 1)) * (1.0f / Y_SCALE); \
            v[j][2] = bflo((unsigned)(x >> 32)) + (__builtin_amdgcn_cvt_f32_fp8(a, 2) + __builtin_amdgcn_cvt_f32_fp8(b, 2)) * (1.0f / Y_SCALE); \
            v[j][3] = bfhi((unsigned)(x >> 32)) + (__builtin_amdgcn_cvt_f32_fp8(a, 3) + __builtin_amdgcn_cvt_f32_fp8(b, 3)) * (1.0f / Y_SCALE); \
            s += (v[j][0] * v[j][0] + v[j][1] * v[j][1]) + (v[j][2] * v[j][2] + v[j][3] * v[j][3]); } \
        if ((r_) + 2 * NGW < NTOK) CB_LOAD(XB, Y0B, Y1B, (r_) + 2 * NGW); \
        const float ri = __builtin_amdgcn_rsqf(wave_sum(s) * (1.0f / DM) + RMS_EPS); \
        if (final) { f32x4* ow = (f32x4*)(OUT + (size_t)(r_) * DM) + lane; \
            _Pragma("unroll") for (int j = 0; j < 4; ++j) ow[64 * j] = v[j] * ri * gv[j]; \
        } else { \
            row_store_bf16(X + (size_t)(r_) * DM, lane, v); \
            if (lane == 0) RN[r_] = ri;                                     \
        } } while (0)
    CB_LOAD(xa, ya0, ya1, gw); CB_LOAD(xb, yb0, yb1, gw + NGW);
    for (int r = gw; r < NTOK; r += 2 * NGW) { CB_ROW(xa, ya0, ya1, r); CB_ROW(xb, yb0, yb1, r + NGW); }
#undef CB_LOAD
#undef CB_ROW
}

constexpr int SC_TC = 32;
constexpr int SC_KK = 0, SC_DD = 8192, SC_AK = 16384, SC_KP = 24576, SC_RR = 32768, SC_VV = 40960, SC_OB = 49152, SC_BS = 57344;
__device__ __forceinline__ void rwkv_scan(Frame& F, const Args& a, const bf16* R, const bf16* K, const bf16* V, const bf16* LD, const bf16* AA, const bf16* GG, bf16* Z) {
    const int bh = F.vcu; if (bh >= BATCH * NHEAD) return;
    const int b = bh / NHEAD, h = bh % NHEAD, tid = F.tid;
    LAS unsigned char* lds = F.lds;
    const float* kkw = (const float*)INP(16); const float* kaw = (const float*)INP(17); const float* rkw = (const float*)INP(18);
    const float* lng = (const float*)INP(20); const float* lnb = (const float*)INP(21);
    const int tl = tid >> 4, c4 = (tid & 15) * 4, col = h * HD + c4;
    const f32x4 kk_w = *(const f32x4*)(kkw + col), ka_w = *(const f32x4*)(kaw + col), rk_w = *(const f32x4*)(rkw + col), ln_g = *(const f32x4*)(lng + col), ln_b = *(const f32x4*)(lnb + col);
    const int rp = tid >> 4, q4 = (tid & 15) * 4;
    f32x4 S0 = {0.f, 0.f, 0.f, 0.f}, S1 = {0.f, 0.f, 0.f, 0.f};
    const size_t rowb = (size_t)b * SEQ;
    v2u nr, nk, nv, nl, na, ng;
#define SC_LOAD(t0) do { const size_t off = (rowb + (t0) + tl) * DM + col; nr = *(const v2u*)(R + off); nk = *(const v2u*)(K + off); nv = *(const v2u*)(V + off); nl = *(const v2u*)(LD + off); na = *(const v2u*)(AA + off); } while (0)
    SC_LOAD(0);
    for (int ch = 0; ch < SEQ / SC_TC; ++ch) {
        const int t0 = ch * SC_TC;
        {
            const f32x4 r = {bflo(nr.x), bfhi(nr.x), bflo(nr.y), bfhi(nr.y)}, k = {bflo(nk.x), bfhi(nk.x), bflo(nk.y), bfhi(nk.y)}, v = {bflo(nv.x), bfhi(nv.x), bflo(nv.y), bfhi(nv.y)};
            const f32x4 l = {bflo(nl.x), bfhi(nl.x), bflo(nl.y), bfhi(nl.y)}, av = {bflo(na.x), bfhi(na.x), bflo(na.y), bfhi(na.y)};
            f32x4 kk = k * kk_w; const float n2 = row16_sum((kk[0] * kk[0] + kk[1] * kk[1]) + (kk[2] * kk[2] + kk[3] * kk[3]));
            kk = kk * (1.0f / fmaxf(sqrtf(n2), 1e-12f));
            const f32x4 kp = k * (1.0f + (av - 1.0f) * ka_w), ak = kk * av;
            f32x4 d; d[0] = __expf(l[0]); d[1] = __expf(l[1]); d[2] = __expf(l[2]); d[3] = __expf(l[3]);
            const f32x4 rb = r * kp * rk_w; const float bs = row16_sum((rb[0] + rb[1]) + (rb[2] + rb[3]));
            const int o = (tl * 64 + c4) * 4;
            *(LAS f32x4*)(lds + SC_KK + o) = kk; *(LAS f32x4*)(lds + SC_DD + o) = d; *(LAS f32x4*)(lds + SC_AK + o) = ak; *(LAS f32x4*)(lds + SC_KP + o) = kp; *(LAS f32x4*)(lds + SC_RR + o) = r; *(LAS f32x4*)(lds + SC_VV + o) = v;
            if ((tid & 15) == 0) *(LAS float*)(lds + SC_BS + tl * 4) = bs;
        }
        __syncthreads();
        if (ch + 1 < SEQ / SC_TC) SC_LOAD(t0 + SC_TC);
        ng = *(const v2u*)(GG + (rowb + t0 + tl) * DM + col);
        {
#define SC_OPS(t, KK, D_, AK, KP, R_, VV) do { const int o_ = ((t) * 64 + q4) * 4; KK = *(const LAS f32x4*)(lds + SC_KK + o_); D_ = *(const LAS f32x4*)(lds + SC_DD + o_); AK = *(const LAS f32x4*)(lds + SC_AK + o_); \
            KP = *(const LAS f32x4*)(lds + SC_KP + o_); R_ = *(const LAS f32x4*)(lds + SC_RR + o_); VV = *(const LAS f32x2*)(lds + SC_VV + ((t) * 64 + 2 * rp) * 4); } while (0)
            f32x4 kk, d, ak, kp, r; f32x2 vv;
            SC_OPS(0, kk, d, ak, kp, r, vv);
            for (int t4 = 0; t4 < SC_TC; t4 += 4) {
                float po0[4], po1[4];
#pragma unroll
                for (int u = 0; u < 4; ++u) {
                    const int t = t4 + u;
                    f32x4 nkk = kk, nd = d, nak = ak, nkp = kp, nr = r; f32x2 nvv = vv;
                    if (t + 1 < SC_TC) SC_OPS(t + 1, nkk, nd, nak, nkp, nr, nvv);
                    const float sk0 = row16_sum((S0[0] * kk[0] + S0[1] * kk[1]) + (S0[2] * kk[2] + S0[3] * kk[3]));
                    const float sk1 = row16_sum((S1[0] * kk[0] + S1[1] * kk[1]) + (S1[2] * kk[2] + S1[3] * kk[3]));
                    S0 = S0 * d + (kp * vv[0] - ak * sk0);
                    S1 = S1 * d + (kp * vv[1] - ak * sk1);
                    po0[u] = (S0[0] * r[0] + S0[1] * r[1]) + (S0[2] * r[2] + S0[3] * r[3]);
                    po1[u] = (S1[0] * r[0] + S1[1] * r[1]) + (S1[2] * r[2] + S1[3] * r[3]);
                    kk = nkk; d = nd; ak = nak; kp = nkp; r = nr; vv = nvv;
                }
#pragma unroll
                for (int u = 0; u < 4; ++u) { po0[u] = row16_sum(po0[u]); po1[u] = row16_sum(po1[u]); }
                if ((tid & 15) == 0) {
#pragma unroll
                    for (int u = 0; u < 4; ++u) *(LAS f32x2*)(lds + SC_OB + ((t4 + u) * 64 + 2 * rp) * 4) = (f32x2){po0[u], po1[u]};
                }
            }
#undef SC_OPS
        }
        __syncthreads();
        {
            const f32x4 o = *(const LAS f32x4*)(lds + SC_OB + (tl * 64 + c4) * 4), v = *(const LAS f32x4*)(lds + SC_VV + (tl * 64 + c4) * 4);
            const float bs = *(const LAS float*)(lds + SC_BS + tl * 4);
            const float mean = row16_sum((o[0] + o[1]) + (o[2] + o[3])) * (1.0f / 64.0f);
            const f32x4 dlt = o - mean; const float var = row16_sum((dlt[0] * dlt[0] + dlt[1] * dlt[1]) + (dlt[2] * dlt[2] + dlt[3] * dlt[3])) * (1.0f / 64.0f);
            const float rs = 1.0f / sqrtf(var + GN_EPS);
            const f32x4 g = {bflo(ng.x), bfhi(ng.x), bflo(ng.y), bfhi(ng.y)};
            const f32x4 z = (dlt * rs * ln_g + ln_b + v * bs) * g;
            v2u w; w.x = pk2(z[0], z[1]); w.y = pk2(z[2], z[3]);
            *(v2u*)(Z + (rowb + t0 + tl) * DM + col) = w;
        }
        __syncthreads();
    }
#undef SC_LOAD
}

constexpr int CS_P = 72, CS_SLOT = 64 * CS_P * 2 + 16;
__device__ __forceinline__ int nt_off(int r, int c) { return r * 128 + ((((c >> 3) ^ (r >> 1)) & 7) << 4) + (c & 7) * 2; }
constexpr int CS_VN = 16 * CS_SLOT;
constexpr int CS_FP = 68;
constexpr int CS_WL = 17 * CS_SLOT, CS_BS = CS_WL + 256, CS_CST = CS_WL + 1024;
enum { SL_S0H = 0, SL_S0L = 1, SL_AT = 2, SL_BT = 3, SL_KT = 4, SL_RT = 5, SL_ATT = 6, SL_BTT = 7, SL_KTT = 8, SL_VT = 9 };
typedef LAS unsigned char* ldsp_t;
template <bool SWB = false, bool SWA = false>
__device__ __forceinline__ void mm_acc(f32x4 (&acc)[2], ldsp_t Bop, ldsp_t Aop, int w, int fr, int fq) {
    const int tj = w >> 1, ti0 = 2 * (w & 1);
#pragma unroll
    for (int ks = 0; ks < 2; ++ks) {
        const int rb = 16 * tj + fr, cb = SWB ? ((4 * ks + fq) ^ ((rb >> 3) & 7)) : (4 * ks + fq);
        const bf16x8 b = *(const LAS bf16x8*)(Bop + (SWB ? (rb * CS_P + 8 * cb) * 2 : nt_off(rb, 8 * cb)));
#pragma unroll
        for (int u = 0; u < 2; ++u) { const int ra = 16 * (ti0 + u) + fr, ca = SWA ? ((4 * ks + fq) ^ ((ra >> 3) & 7)) : (4 * ks + fq);
            const bf16x8 a = *(const LAS bf16x8*)(Aop + (SWA ? (ra * CS_P + 8 * ca) * 2 : nt_off(ra, 8 * ca)));
            acc[u] = __builtin_amdgcn_mfma_f32_16x16x32_bf16(a, b, acc[u], 0, 0, 0); }
    }
}
template <bool SW = false>
__device__ __forceinline__ void ld_b(bf16x8 (&b)[2], ldsp_t Bop, int w, int fr, int fq) {
    const int rb = 16 * (w >> 1) + fr;
#pragma unroll
    for (int ks = 0; ks < 2; ++ks) { const int cb = SW ? ((4 * ks + fq) ^ ((rb >> 3) & 7)) : (4 * ks + fq); b[ks] = *(const LAS bf16x8*)(Bop + (SW ? (rb * CS_P + 8 * cb) * 2 : nt_off(rb, 8 * cb))); }
}
template <bool SW = false>
__device__ __forceinline__ void ld_a(bf16x8 (&a)[2][2], ldsp_t Aop, int w, int fr, int fq) {
#pragma unroll
    for (int ks = 0; ks < 2; ++ks)
#pragma unroll
        for (int u = 0; u < 2; ++u) { const int ra = 16 * (2 * (w & 1) + u) + fr, ca = SW ? ((4 * ks + fq) ^ ((ra >> 3) & 7)) : (4 * ks + fq); a[ks][u] = *(const LAS bf16x8*)(Aop + (SW ? (ra * CS_P + 8 * ca) * 2 : nt_off(ra, 8 * ca))); }
}
__device__ __forceinline__ void mma(f32x4 (&acc)[2], const bf16x8 (&b)[2], const bf16x8 (&a)[2][2]) {
#pragma unroll
    for (int ks = 0; ks < 2; ++ks)
#pragma unroll
        for (int u = 0; u < 2; ++u) acc[u] = __builtin_amdgcn_mfma_f32_16x16x32_bf16(a[ks][u], b[ks], acc[u], 0, 0, 0);
}
__device__ __forceinline__ void cs_store(ldsp_t dst, int r, int c0, const f32x4& v) { v2u w; w.x = cvt2(v[0], v[1]); w.y = cvt2(v[2], v[3]); *(LAS v2u*)(dst + nt_off(r, c0)) = w; }
__device__ __forceinline__ f32x4 cs_load(ldsp_t src, int r, int c0) { const v2u w = *(const LAS v2u*)(src + nt_off(r, c0)); return (f32x4){bflo(w.x), bfhi(w.x), bflo(w.y), bfhi(w.y)}; }
#define CS_SL(i) (lds + (i) * CS_SLOT)
#define CS_ZERO(a) do { a[0] = (f32x4){0.f, 0.f, 0.f, 0.f}; a[1] = a[0]; } while (0)
#define CS_FOR_U _Pragma("unroll") for (int u = 0; u < 2; ++u)
#define CS_BAR() do { LDS_WAIT(); __builtin_amdgcn_s_barrier(); asm volatile("" ::: "memory"); } while (0)
template <int CTRL> __device__ __forceinline__ float dppf8(float v) { return dppf<CTRL>(v); }
__device__ __forceinline__ float row8_sum(float v) { v += dppf<0xB1>(v); v += dppf<0x4E>(v); v += dppf<0x141>(v); return v; }
__device__ __forceinline__ void rwkv_scan_chunked(Frame& F, const bf16* R, const bf16* K, const bf16* V, const bf16* LO, const bf16* WLU, const float* w0p, const float* a0p, bf16* Z) {
    const int bh = F.vcu; if (bh >= BATCH * NHEAD) return;
    const int b = bh / NHEAD, h = bh % NHEAD;
    int tid = threadIdx.x; asm volatile("" : "+v"(tid));
    const int lane = tid & 63, w = __builtin_amdgcn_readfirstlane(tid >> 6), fr = lane & 15, fq = lane >> 4;
    ldsp_t lds = F.lds;
    const int tj = w >> 1, ti0 = 2 * (w & 1), er = 16 * tj + fr;
    const int tl = tid >> 3, c8 = (tid & 7) * 8, col = h * HD + c8;
    const float* kkw = (const float*)INP(16); const float* kaw = (const float*)INP(17); const float* rkw = (const float*)INP(18);
    const float* lng = (const float*)INP(20); const float* lnb = (const float*)INP(21);
    if (tid < 64) { LAS float* cst = (LAS float*)(lds + CS_CST); cst[tid] = kkw[h * HD + tid]; cst[64 + tid] = kaw[h * HD + tid]; cst[128 + tid] = rkw[h * HD + tid]; cst[192 + tid] = lng[h * HD + tid]; cst[256 + tid] = lnb[h * HD + tid]; }
#define CS_CLD(arr, j) do { const f32x4 c0_ = *(const LAS f32x4*)(lds + CS_CST + ((j) * 64 + c8) * 4), c1_ = *(const LAS f32x4*)(lds + CS_CST + ((j) * 64 + c8 + 4) * 4); \
                            arr[0] = c0_[0]; arr[1] = c0_[1]; arr[2] = c0_[2]; arr[3] = c0_[3]; arr[4] = c1_[0]; arr[5] = c1_[1]; arr[6] = c1_[2]; arr[7] = c1_[3]; } while (0)
    const size_t rowb = (size_t)b * SEQ;
    for (int i = tid; i < 2 * CS_SLOT / 4; i += 512) ((LAS unsigned*)lds)[i] = 0u;
    v4u nr, nk, nv;
#define CS_LOAD(t0) do { const size_t off = (rowb + (t0) + tl) * DM + col; nr = *(const v4u*)(R + off); nk = *(const v4u*)(K + off); nv = *(const v4u*)(V + off); } while (0)
    f32x4 w0v[2], a0v[2];
#pragma unroll
    for (int u = 0; u < 2; ++u) { w0v[u] = *(const f32x4*)(w0p + h * HD + 16 * (ti0 + u) + 4 * fq); a0v[u] = *(const f32x4*)(a0p + h * HD + 16 * (ti0 + u) + 4 * fq); }
#define CS_UNPK(PK_, o) do { o[0] = bflo((PK_)[0]); o[1] = bfhi((PK_)[0]); o[2] = bflo((PK_)[1]); o[3] = bfhi((PK_)[1]); o[4] = bflo((PK_)[2]); o[5] = bfhi((PK_)[2]); o[6] = bflo((PK_)[3]); o[7] = bfhi((PK_)[3]); } while (0)
    const int st_t = tid >> 3, st_part = tid & 7, st_tile = tid >> 7, st_k = (tid >> 1) & 63, st_hf = tid & 1;
    const ldsp_t st_ldst = CS_SL(2 + (st_part >> 1)), st_wdst = CS_SL(6 + st_tile);
    v4u sl0, sl1, sl2, sl3, sw0, sw1, sw2, sw3;
    const v4u* st_wsrc = (const v4u*)(WLU + (size_t)((st_tile < 2 ? st_tile : 2) * DM + rowmap(1, h * HD + st_k)) * 256 + 64 * st_tile + 32 * st_hf);
#define CS_STAGE_LD(t0) do { const v4u* src = (const v4u*)(LO + (rowb + (t0) + st_t) * 256 + 32 * st_part); sl0 = src[0]; sl1 = src[1]; sl2 = src[2]; sl3 = src[3]; \
                              sw0 = st_wsrc[0]; sw1 = st_wsrc[1]; sw2 = st_wsrc[2]; sw3 = st_wsrc[3]; } while (0)
#define CS_STAGE_ST() do { const int lc_ = (st_part & 1) * 32, wc_ = 32 * st_hf; \
        *(LAS v4u*)(st_ldst + nt_off(st_t, lc_)) = sl0; *(LAS v4u*)(st_ldst + nt_off(st_t, lc_ + 8)) = sl1; *(LAS v4u*)(st_ldst + nt_off(st_t, lc_ + 16)) = sl2; *(LAS v4u*)(st_ldst + nt_off(st_t, lc_ + 24)) = sl3; \
        *(LAS v4u*)(st_wdst + nt_off(st_k, wc_)) = sw0; *(LAS v4u*)(st_wdst + nt_off(st_k, wc_ + 8)) = sw1; *(LAS v4u*)(st_wdst + nt_off(st_k, wc_ + 16)) = sw2; *(LAS v4u*)(st_wdst + nt_off(st_k, wc_ + 24)) = sw3; } while (0)
    CS_STAGE_LD(0); CS_STAGE_ST();
    CS_LOAD(0);
    for (int ch = 0; ch < SEQ / 64; ++ch) {
        const int t0 = ch * 64;
        LAS float* cw = (LAS float*)CS_SL(10);
        float r_[8], k_[8], v_[8], a_[8], gg[8];
        CS_UNPK(nr, r_); CS_UNPK(nk, k_); CS_UNPK(nv, v_);
        const v4u nv_keep = nv;
        CS_BAR();
        {
            f32x4 aw[2], aa[2], ag[2];
            CS_ZERO(aw); mm_acc(aw, CS_SL(2), CS_SL(6), w, fr, fq);
            CS_ZERO(aa); mm_acc(aa, CS_SL(3), CS_SL(7), w, fr, fq);
            CS_ZERO(ag); mm_acc(ag, CS_SL(4), CS_SL(8), w, fr, fq); mm_acc(ag, CS_SL(5), CS_SL(9), w, fr, fq);
            CS_FOR_U { const int c0 = 16 * (ti0 + u) + 4 * fq; f32x4 lv, av;
#pragma unroll
                for (int i = 0; i < 4; ++i) { float l = -0.6065306597126334f * sigmoidf_(aw[u][i] + w0v[u][i]);
                    l += dppf<0x111>(l); l += dppf<0x112>(l); l += dppf<0x114>(l); l += dppf<0x118>(l);
                    lv[i] = l; av[i] = sigmoidf_(aa[u][i] + a0v[u][i]); }
                *(LAS f32x4*)(CS_SL(10) + (er * CS_FP + c0) * 4) = lv; *(LAS f32x4*)(CS_SL(12) + (er * CS_FP + c0) * 4) = av; *(LAS f32x4*)(CS_SL(14) + (er * CS_FP + c0) * 4) = ag[u]; }
            CS_BAR();
            const LAS float* af = (const LAS float*)CS_SL(12) + tl * CS_FP + c8; const LAS float* gf = (const LAS float*)CS_SL(14) + tl * CS_FP + c8;
#pragma unroll
            for (int e = 0; e < 8; ++e) { a_[e] = af[e]; gg[e] = gf[e]; }
        }
        if (ch + 1 < SEQ / 64) CS_LOAD(t0 + 64);
        {
            float kk[8], kp[8], n2 = 0.f, bsum = 0.f, kkw_[8], kaw_[8], rkw_[8];
            CS_CLD(kkw_, 0); CS_CLD(kaw_, 1); CS_CLD(rkw_, 2);
#pragma unroll
            for (int e = 0; e < 8; ++e) { kk[e] = k_[e] * kkw_[e]; n2 += kk[e] * kk[e]; kp[e] = k_[e] * (1.0f + (a_[e] - 1.0f) * kaw_[e]); bsum += r_[e] * kp[e] * rkw_[e]; }
            n2 = row8_sum(n2); bsum = row8_sum(bsum);
            const float inv = __builtin_amdgcn_rsqf(fmaxf(n2, 1e-24f));
            f32x4 at0, at1, bt0, bt1, kt0, kt1, rt0, rt1;
            float atv[8], btv[8], ktv[8], rtv[8];
#pragma unroll
            for (int e = 0; e < 8; ++e) {
                const float off = (tl >= 16 ? cw[15 * CS_FP + c8 + e] : 0.f) + (tl >= 32 ? cw[31 * CS_FP + c8 + e] : 0.f) + (tl >= 48 ? cw[47 * CS_FP + c8 + e] : 0.f);
                const float c1 = cw[tl * CS_FP + c8 + e] + off, c0 = ((tl & 15) ? cw[(tl - 1) * CS_FP + c8 + e] : 0.f) + off;
                const float kn = kk[e] * inv, ep = __expf(c1), em = __expf(-c1);
                atv[e] = kn * __expf(c0); btv[e] = kn * a_[e] * em; ktv[e] = kp[e] * em; rtv[e] = r_[e] * ep;
                if (tl == 63) ((LAS float*)(lds + CS_WL))[c8 + e] = ep; }
            at0 = (f32x4){atv[0], atv[1], atv[2], atv[3]}; at1 = (f32x4){atv[4], atv[5], atv[6], atv[7]};
            bt0 = (f32x4){btv[0], btv[1], btv[2], btv[3]}; bt1 = (f32x4){btv[4], btv[5], btv[6], btv[7]};
            kt0 = (f32x4){ktv[0], ktv[1], ktv[2], ktv[3]}; kt1 = (f32x4){ktv[4], ktv[5], ktv[6], ktv[7]};
            rt0 = (f32x4){rtv[0], rtv[1], rtv[2], rtv[3]}; rt1 = (f32x4){rtv[4], rtv[5], rtv[6], rtv[7]};
            cs_store(CS_SL(SL_AT), tl, c8, at0); cs_store(CS_SL(SL_AT), tl, c8 + 4, at1);
            cs_store(CS_SL(SL_BT), tl, c8, bt0); cs_store(CS_SL(SL_BT), tl, c8 + 4, bt1);
            cs_store(CS_SL(SL_KT), tl, c8, kt0); cs_store(CS_SL(SL_KT), tl, c8 + 4, kt1);
            cs_store(CS_SL(SL_RT), tl, c8, rt0); cs_store(CS_SL(SL_RT), tl, c8 + 4, rt1);
            *(LAS v4u*)(lds + CS_VN + nt_off(tl, c8)) = nv_keep;
            const int tsw = (((tl >> 3) ^ (tid & 7)) << 3) | (tl & 7);
#pragma unroll
            for (int e = 0; e < 8; e += 2) {
                const unsigned pa = cvt2(atv[e], atv[e + 1]), pb = cvt2(btv[e], btv[e + 1]), pk = cvt2(ktv[e], ktv[e + 1]), pv = cvt2(v_[e], v_[e + 1]);
                *(LAS unsigned short*)(CS_SL(SL_ATT) + ((c8 + e) * CS_P + tsw) * 2) = (unsigned short)pa; *(LAS unsigned short*)(CS_SL(SL_ATT) + ((c8 + e + 1) * CS_P + tsw) * 2) = (unsigned short)(pa >> 16);
                *(LAS unsigned short*)(CS_SL(SL_BTT) + ((c8 + e) * CS_P + tsw) * 2) = (unsigned short)pb; *(LAS unsigned short*)(CS_SL(SL_BTT) + ((c8 + e + 1) * CS_P + tsw) * 2) = (unsigned short)(pb >> 16);
                *(LAS unsigned short*)(CS_SL(SL_KTT) + ((c8 + e) * CS_P + tsw) * 2) = (unsigned short)pk; *(LAS unsigned short*)(CS_SL(SL_KTT) + ((c8 + e + 1) * CS_P + tsw) * 2) = (unsigned short)(pk >> 16);
                *(LAS unsigned short*)(CS_SL(SL_VT) + ((c8 + e) * CS_P + tsw) * 2) = (unsigned short)pv; *(LAS unsigned short*)(CS_SL(SL_VT) + ((c8 + e + 1) * CS_P + tsw) * 2) = (unsigned short)(pv >> 16); }
            if ((tid & 7) == 0) ((LAS float*)(lds + CS_BS))[tl] = bsum;
        }
        CS_BAR();
        {
            bf16x8 bA[2], bR[2], bB[2], aB[2][2], aK[2][2], aA[2][2];
            ld_b(bA, CS_SL(SL_AT), w, fr, fq); ld_a(aB, CS_SL(SL_BT), w, fr, fq); ld_b(bB, CS_SL(SL_BT), w, fr, fq); ld_a(aA, CS_SL(SL_AT), w, fr, fq);
            ld_a(aK, CS_SL(SL_KT), w, fr, fq); ld_b(bR, CS_SL(SL_RT), w, fr, fq);
            f32x4 pab[2], pba[2], pak[2], prb[2], prk[2];
            CS_ZERO(pab); mma(pab, bA, aB); CS_ZERO(pba); mma(pba, bB, aA); CS_ZERO(pak); mma(pak, bA, aK); CS_ZERO(prb); mma(prb, bR, aB); CS_ZERO(prk); mma(prk, bR, aK);
            CS_FOR_U { const int c0 = 16 * (ti0 + u) + 4 * fq; f32x4 x, t, xt, ak, rb_, rk;
#pragma unroll
                for (int i = 0; i < 4; ++i) { x[i] = (c0 + i < er) ? -pab[u][i] : 0.f; t[i] = x[i] + ((c0 + i == er) ? 1.f : 0.f); xt[i] = (c0 + i > er) ? -pba[u][i] : 0.f;
                    ak[i] = (c0 + i < er) ? pak[u][i] : 0.f; rb_[i] = (c0 + i <= er) ? prb[u][i] : 0.f; rk[i] = (c0 + i <= er) ? prk[u][i] : 0.f; }
                cs_store(CS_SL(10), er, c0, x); cs_store(CS_SL(12), er, c0, t); cs_store(CS_SL(11), er, c0, xt); cs_store(CS_SL(13), er, c0, ak); cs_store(CS_SL(14), er, c0, rb_); cs_store(CS_SL(15), er, c0, rk); }
        }
        CS_BAR();
        f32x4 acc[2], acc2[2];
#define CS_PLAIN(dst, bop, aop) do { CS_ZERO(acc); mm_acc(acc, CS_SL(bop), CS_SL(aop), w, fr, fq); CS_FOR_U cs_store(CS_SL(dst), er, 16 * (ti0 + u) + 4 * fq, acc[u]); } while (0)
#define CS_TUPD(dst, told, xt) do { CS_ZERO(acc); mm_acc(acc, CS_SL(told), CS_SL(xt), w, fr, fq); CS_FOR_U { const int c0 = 16 * (ti0 + u) + 4 * fq; cs_store(CS_SL(dst), er, c0, acc[u] + cs_load(CS_SL(told), er, c0)); } } while (0)
#define CS_SQ(dX, dXT, dT, sX, sXT, sT) do { bf16x8 bX_[2], bXT_[2], bT_[2], aX_[2][2], aXT_[2][2]; f32x4 p1_[2], p2_[2], p3_[2]; \
            ld_b(bX_, CS_SL(sX), w, fr, fq); ld_a(aXT_, CS_SL(sXT), w, fr, fq); ld_b(bXT_, CS_SL(sXT), w, fr, fq); ld_a(aX_, CS_SL(sX), w, fr, fq); ld_b(bT_, CS_SL(sT), w, fr, fq); \
            CS_ZERO(p1_); mma(p1_, bX_, aXT_); CS_ZERO(p2_); mma(p2_, bXT_, aX_); CS_ZERO(p3_); mma(p3_, bT_, aXT_); \
            CS_FOR_U { const int c0 = 16 * (ti0 + u) + 4 * fq; cs_store(CS_SL(dX), er, c0, p1_[u]); cs_store(CS_SL(dXT), er, c0, p2_[u]); cs_store(CS_SL(dT), er, c0, p3_[u] + cs_load(CS_SL(sT), er, c0)); \
                mloc = fmaxf(mloc, fmaxf(fmaxf(fabsf(p1_[u][0]), fabsf(p1_[u][1])), fmaxf(fabsf(p1_[u][2]), fabsf(p1_[u][3])))); } } while (0)
#define CS_PLAINM(dst, bop, aop) do { CS_ZERO(acc); mm_acc(acc, CS_SL(bop), CS_SL(aop), w, fr, fq); CS_FOR_U { cs_store(CS_SL(dst), er, 16 * (ti0 + u) + 4 * fq, acc[u]); \
            mloc = fmaxf(mloc, fmaxf(fmaxf(fabsf(acc[u][0]), fabsf(acc[u][1])), fmaxf(fabsf(acc[u][2]), fabsf(acc[u][3])))); } } while (0)
#define CS_PUBMAX(lev) do { float m_ = mloc; m_ = fmaxf(m_, dppf<0xB1>(m_)); m_ = fmaxf(m_, dppf<0x4E>(m_)); m_ = fmaxf(m_, dppf<0x141>(m_)); m_ = fmaxf(m_, dppf<0x140>(m_));   \
            const unsigned mb_ = __builtin_bit_cast(unsigned, m_); unsigned u0_ = (unsigned)__builtin_amdgcn_readlane((int)mb_, 0), u1_ = (unsigned)__builtin_amdgcn_readlane((int)mb_, 16), u2_ = (unsigned)__builtin_amdgcn_readlane((int)mb_, 32), u3_ = (unsigned)__builtin_amdgcn_readlane((int)mb_, 48); \
            u0_ = u0_ > u1_ ? u0_ : u1_; u2_ = u2_ > u3_ ? u2_ : u3_; u0_ = u0_ > u2_ ? u0_ : u2_;     \
            if (lane == 0) xm[((lev) & 1) * 8 + w] = __builtin_bit_cast(float, u0_); } while (0)
#define CS_GETMAX(lev) ({ const f32x4 a_ = *(const LAS f32x4*)(xm + ((lev) & 1) * 8), b_ = *(const LAS f32x4*)(xm + ((lev) & 1) * 8 + 4); \
            __builtin_bit_cast(float, __builtin_amdgcn_readfirstlane(__builtin_bit_cast(int, fmaxf(fmaxf(fmaxf(a_[0], a_[1]), fmaxf(a_[2], a_[3])), fmaxf(fmaxf(b_[0], b_[1]), fmaxf(b_[2], b_[3])))))); })
        constexpr float CS_TH = 2.44140625e-4f;
        LAS float* xm = (LAS float*)(lds + CS_BS + 256);
        int tslot = 12; float mloc = 0.f;
        { bf16x8 bX[2], bXT[2], bV[2], aX[2][2], aXT[2][2], aK[2][2]; f32x4 p1[2], p2[2], p3[2];
          ld_b(bX, CS_SL(10), w, fr, fq); ld_a(aXT, CS_SL(11), w, fr, fq); ld_b(bXT, CS_SL(11), w, fr, fq); ld_a(aX, CS_SL(10), w, fr, fq); ld_b<true>(bV, CS_SL(SL_VT), w, fr, fq); ld_a(aK, CS_SL(13), w, fr, fq);
          CS_ZERO(p1); mma(p1, bX, aXT); CS_ZERO(p2); mma(p2, bXT, aX); CS_ZERO(p3); mma(p3, bV, aK);
          CS_FOR_U { const int c0 = 16 * (ti0 + u) + 4 * fq; cs_store(CS_SL(2), er, c0, p1[u]); cs_store(CS_SL(3), er, c0, p2[u]); cs_store(CS_SL(4), er, c0, p3[u]);
              mloc = fmaxf(mloc, fmaxf(fmaxf(fabsf(p1[u][0]), fabsf(p1[u][1])), fmaxf(fabsf(p1[u][2]), fabsf(p1[u][3])))); } }
        CS_PUBMAX(0);
        CS_BAR();
        if (CS_GETMAX(0) >= CS_TH) {
            mloc = 0.f; CS_SQ(10, 11, 13, 2, 3, 12); CS_PUBMAX(1);
            CS_BAR(); tslot = 13;
            if (CS_GETMAX(1) >= CS_TH) {
                mloc = 0.f; CS_SQ(2, 3, 12, 10, 11, 13); CS_PUBMAX(0);
                CS_BAR(); tslot = 12;
                if (CS_GETMAX(0) >= CS_TH) {
                    mloc = 0.f; CS_SQ(10, 11, 13, 2, 3, 12); CS_PUBMAX(1);
                    CS_BAR(); tslot = 13;
                    if (CS_GETMAX(1) >= CS_TH) {
                        mloc = 0.f;
                        { bf16x8 bXT[2], bT[2], aX[2][2], aXT[2][2]; f32x4 p1[2], p2[2];
                          ld_b(bXT, CS_SL(11), w, fr, fq); ld_a(aX, CS_SL(10), w, fr, fq); ld_b(bT, CS_SL(13), w, fr, fq); ld_a(aXT, CS_SL(11), w, fr, fq);
                          CS_ZERO(p1); mma(p1, bXT, aX); CS_ZERO(p2); mma(p2, bT, aXT);
                          CS_FOR_U { const int c0 = 16 * (ti0 + u) + 4 * fq; cs_store(CS_SL(3), er, c0, p1[u]); cs_store(CS_SL(12), er, c0, p2[u] + cs_load(CS_SL(13), er, c0));
                              mloc = fmaxf(mloc, fmaxf(fmaxf(fabsf(p1[u][0]), fabsf(p1[u][1])), fmaxf(fabsf(p1[u][2]), fabsf(p1[u][3])))); } }
                        CS_PUBMAX(0);
                        CS_BAR(); tslot = 12;
                        if (CS_GETMAX(0) >= CS_TH) {
                            CS_TUPD(13, 12, 3);
                            CS_BAR(); tslot = 13;
                        }
                    }
                }
            }
        }
        { bf16x8 bAtt[2], bY[2], aT[2][2];
          ld_a(aT, CS_SL(tslot), w, fr, fq); ld_b<true>(bAtt, CS_SL(SL_ATT), w, fr, fq); ld_b(bY, CS_SL(4), w, fr, fq);
          CS_ZERO(acc); mma(acc, bAtt, aT); CS_ZERO(acc2); mma(acc2, bY, aT);
          CS_FOR_U { const int c0 = 16 * (ti0 + u) + 4 * fq; cs_store(CS_SL(2), er, c0, -acc[u]); cs_store(CS_SL(10), er, c0, -acc2[u]); } }
        CS_BAR();
        { bf16x8 b14[2], b15[2], bBtt[2], a2[2][2], aV[2][2], a10[2][2]; f32x4 pm[2];
          ld_b(b14, CS_SL(14), w, fr, fq); ld_a(a2, CS_SL(2), w, fr, fq); ld_b(b15, CS_SL(15), w, fr, fq); ld_a<true>(aV, CS_SL(SL_VT), w, fr, fq); ld_a(a10, CS_SL(10), w, fr, fq); ld_b<true>(bBtt, CS_SL(SL_BTT), w, fr, fq);
          CS_ZERO(acc); mma(acc, b14, a2); CS_ZERO(acc2); mma(acc2, b15, aV); mma(acc2, b14, a10); CS_ZERO(pm); mma(pm, bBtt, a2);
          const float wl = ((const LAS float*)(lds + CS_WL))[er];
          CS_FOR_U { const int c0 = 16 * (ti0 + u) + 4 * fq; f32x4 m;
#pragma unroll
              for (int i = 0; i < 4; ++i) m[i] = (pm[u][i] + ((c0 + i == er) ? 1.f : 0.f)) * wl;
              cs_store(CS_SL(3), er, c0, acc[u] + cs_load(CS_SL(SL_RT), er, c0)); cs_store(CS_SL(11), er, c0, acc2[u]); cs_store(CS_SL(12), er, c0, m); } }
        CS_BAR();
        if (ch + 1 < SEQ / 64) CS_STAGE_LD(t0 + 64);
        { bf16x8 b3[2], bV[2], b10[2], bH[2], bL[2], aH[2][2], aL[2][2], aK[2][2], aB[2][2], a12[2][2];
          ld_b(b3, CS_SL(3), w, fr, fq); ld_a(aH, CS_SL(SL_S0H), w, fr, fq); ld_a(aL, CS_SL(SL_S0L), w, fr, fq);
          ld_b<true>(bV, CS_SL(SL_VT), w, fr, fq); ld_a<true>(aK, CS_SL(SL_KTT), w, fr, fq); ld_b(b10, CS_SL(10), w, fr, fq); ld_a<true>(aB, CS_SL(SL_BTT), w, fr, fq);
          ld_a(a12, CS_SL(12), w, fr, fq); ld_b(bH, CS_SL(SL_S0H), w, fr, fq); ld_b(bL, CS_SL(SL_S0L), w, fr, fq);
          CS_ZERO(acc); mma(acc, b3, aH); mma(acc, b3, aL);
          CS_ZERO(acc2); mma(acc2, bV, aK); mma(acc2, b10, aB);
          CS_FOR_U { const f32x4 wl4 = *(const LAS f32x4*)(lds + CS_WL + (16 * (ti0 + u) + 4 * fq) * 4); acc2[u] = acc2[u] * wl4; }
          mma(acc2, bH, a12); mma(acc2, bL, a12);
          CS_FOR_U { const int c0 = 16 * (ti0 + u) + 4 * fq; *(LAS f32x4*)(CS_SL(13) + (er * CS_FP + c0) * 4) = acc[u] + cs_load(CS_SL(11), er, c0); } }
        CS_BAR();
        CS_FOR_U { const int c0 = 16 * (ti0 + u) + 4 * fq; f32x4 hi, lo;
#pragma unroll
            for (int i = 0; i < 4; i += 2) { const unsigned ph = cvt2(acc2[u][i], acc2[u][i + 1]); hi[i] = bflo(ph); hi[i + 1] = bfhi(ph); lo[i] = acc2[u][i] - hi[i]; lo[i + 1] = acc2[u][i + 1] - hi[i + 1]; }
            cs_store(CS_SL(SL_S0H), er, c0, hi); cs_store(CS_SL(SL_S0L), er, c0, lo); }
        if (ch + 1 < SEQ / 64) CS_STAGE_ST();
        {
            const LAS float* ob = (const LAS float*)CS_SL(13) + tl * CS_FP + c8;
            const f32x4 o0 = *(const LAS f32x4*)ob, o1 = *(const LAS f32x4*)(ob + 4);
            const v4u vw = *(const LAS v4u*)(lds + CS_VN + nt_off(tl, c8));
            const float bs = ((const LAS float*)(lds + CS_BS))[tl];
            float o[8] = {o0[0], o0[1], o0[2], o0[3], o1[0], o1[1], o1[2], o1[3]}, vv[8];
            CS_UNPK(vw, vv);
            float sm = 0.f;
#pragma unroll
            for (int e = 0; e < 8; ++e) sm += o[e];
            const float mean = row8_sum(sm) * (1.0f / 64.0f); float q = 0.f;
#pragma unroll
            for (int e = 0; e < 8; ++e) { o[e] -= mean; q += o[e] * o[e]; }
            const float rs = __builtin_amdgcn_rsqf(row8_sum(q) * (1.0f / 64.0f) + GN_EPS);
            float z[8], lng_[8], lnb_[8];
            CS_CLD(lng_, 3); CS_CLD(lnb_, 4);
#pragma unroll
            for (int e = 0; e < 8; ++e) z[e] = (o[e] * rs * lng_[e] + lnb_[e] + vv[e] * bs) * gg[e];
            *(v4u*)(Z + (rowb + t0 + tl) * DM + col) = (v4u){cvt2(z[0], z[1]), cvt2(z[2], z[3]), cvt2(z[4], z[5]), cvt2(z[6], z[7])};
        }
    }
#undef CS_LOAD
#undef CS_CLD
#undef CS_STAGE_LD
#undef CS_STAGE_ST
#undef CS_UNPK
#undef CS_PLAIN
#undef CS_PLAINM
#undef CS_PUBMAX
#undef CS_GETMAX
#undef CS_TUPD
}
constexpr int RT_WB = 0, RT_WBP = 1040;
constexpr int RT_LG = 112640;
constexpr int RT_RI = 131072;
constexpr int RT_DE = 131584;
constexpr int RT_DG = RT_DE + 1024;
constexpr int RT_LR = RT_DG + 1024;
constexpr int RT_LC = RT_LR + 1024;
constexpr int RT_BS = RT_LC + 128;
__device__ __forceinline__ void moe_router(Frame& F, const bf16* X, const float* g, const float* wg, const float* bg, const float* we, const float* be, float* RINV, int* pairlist, float* gate, unsigned* cnt) {
    LAS unsigned char* lds = F.lds; const int tid = F.tid, lane = F.lane;
    LAS float* LG = (LAS float*)(lds + RT_LG); LAS float* RI = (LAS float*)(lds + RT_RI);
    const int rows_per = NTOK / F.G;
    const int row0 = F.vcu * rows_per + F.wave * 16;
    const int r = lane & 15, kq = lane >> 4, j = lane & 15;
    f32x4 acc0 = {0.f, 0.f, 0.f, 0.f}, acc1 = {0.f, 0.f, 0.f, 0.f}, acc2 = {0.f, 0.f, 0.f, 0.f};
    float ssq = 0.f;
    if (tid < 32) *(LAS int*)(lds + RT_LC + tid * 4) = 0;
#define RT_SPLIT_ST(col, kk_, w_) do { const float w0_ = (w_); const unsigned h_ = cvt2(w0_, 0.f) & 0xffffu; const float r1_ = w0_ - bflo(h_); const unsigned l_ = cvt2(r1_, 0.f) & 0xffffu; \
        const unsigned m_ = cvt2(r1_ - bflo(l_), 0.f) & 0xffffu; LAS unsigned char* p_ = lds + RT_WB + (col) * RT_WBP + (kk_) * 2; \
        *(LAS unsigned short*)p_ = (unsigned short)h_; *(LAS unsigned short*)(p_ + 36 * RT_WBP) = (unsigned short)l_; *(LAS unsigned short*)(p_ + 72 * RT_WBP) = (unsigned short)m_; } while (0)
    for (int half = 0; half < 2; ++half) {
        __syncthreads();
        {
            const int kk = tid; const float gk = g[half * 512 + kk]; const f32x4* wr_ = (const f32x4*)(we + (size_t)(half * 512 + kk) * 32);
#pragma unroll
            for (int c4 = 0; c4 < 32; c4 += 4) { const f32x4 w = wr_[c4 >> 2] * gk;
                RT_SPLIT_ST(c4, kk, w[0]); RT_SPLIT_ST(c4 + 1, kk, w[1]); RT_SPLIT_ST(c4 + 2, kk, w[2]); RT_SPLIT_ST(c4 + 3, kk, w[3]); } }
        { const int kk = tid; const f32x4 w = *(const f32x4*)(wg + (size_t)(half * 512 + kk) * 4) * g[half * 512 + kk];
            RT_SPLIT_ST(32, kk, w[0]); RT_SPLIT_ST(33, kk, w[1]); RT_SPLIT_ST(34, kk, w[2]); RT_SPLIT_ST(35, kk, w[3]); }
        __syncthreads();
        const bf16* xp = X + (size_t)(row0 + r) * DM + half * 512 + kq * 8;
        const LAS unsigned char* wb0 = lds + RT_WB + j * RT_WBP + kq * 16, * wb1 = wb0 + 16 * RT_WBP, * wb2 = lds + RT_WB + (32 + (j & 3)) * RT_WBP + kq * 16;
        for (int b8 = 0; b8 < 2; ++b8) {
            v4u xw[8];
#pragma unroll
            for (int i = 0; i < 8; ++i) xw[i] = *(const v4u*)(xp + (b8 * 8 + i) * 32);
#pragma unroll
            for (int i = 0; i < 8; ++i) { const int ko = (b8 * 8 + i) * 64;
#pragma unroll
                for (int e = 0; e < 4; ++e) { const float a0 = bflo(xw[i][e]), a1 = bfhi(xw[i][e]); ssq += a0 * a0 + a1 * a1; }
                const bf16x8 a = __builtin_bit_cast(bf16x8, xw[i]);
#pragma unroll
                for (int p = 0; p < 3; ++p) {
                    const bf16x8 b0 = *(const LAS bf16x8*)(wb0 + p * 36 * RT_WBP + ko), b1 = *(const LAS bf16x8*)(wb1 + p * 36 * RT_WBP + ko);
                    bf16x8 b2 = *(const LAS bf16x8*)(wb2 + p * 36 * RT_WBP + ko); if (j >= 4) b2 = (bf16x8){0, 0, 0, 0, 0, 0, 0, 0};
                    acc0 = __builtin_amdgcn_mfma_f32_16x16x32_bf16(a, b0, acc0, 0, 0, 0);
                    acc1 = __builtin_amdgcn_mfma_f32_16x16x32_bf16(a, b1, acc1, 0, 0, 0);
                    acc2 = __builtin_amdgcn_mfma_f32_16x16x32_bf16(a, b2, acc2, 0, 0, 0); }
            }
        }
    }
#undef RT_SPLIT_ST
    ssq += __shfl_xor(ssq, 16); ssq += __shfl_xor(ssq, 32);
    const float rinv = 1.0f / sqrtf(ssq * (1.0f / DM) + RMS_EPS);
    if (kq == 0) { RI[F.wave * 16 + r] = rinv; RINV[row0 + r] = rinv; }
    LDS_WAIT(); asm volatile("" ::: "memory");
    {
        const float be0 = be[j], be1 = be[16 + j], bgj = bg[j & 3];
#pragma unroll
        for (int reg = 0; reg < 4; ++reg) { const int lr = F.wave * 16 + 4 * kq + reg; const float ri = RI[lr];
            LG[lr * 36 + j] = acc0[reg] * ri + be0; LG[lr * 36 + 16 + j] = acc1[reg] * ri + be1; if (j < 4) LG[lr * 36 + 32 + j] = acc2[reg] * ri + bgj; }
    }
    __syncthreads();
    if (tid < rows_per) {
        const LAS float* lg = LG + tid * 36;
        int gi = 0; float gm = lg[32];
#pragma unroll
        for (int c = 1; c < 4; ++c) { const float v = lg[32 + c]; if (v > gm) { gm = v; gi = c; } }
        float gs = 0.f;
#pragma unroll
        for (int c = 0; c < 4; ++c) gs += __expf(lg[32 + c] - gm);
        const float pg = 1.0f / gs;
        const LAS float* el = lg + gi * 8;
        int e1 = 0; float m1 = el[0];
#pragma unroll
        for (int c = 1; c < 8; ++c) { const float v = el[c]; if (v > m1) { m1 = v; e1 = c; } }
        int e2 = e1 == 0 ? 1 : 0; float m2 = el[e2];
#pragma unroll
        for (int c = 0; c < 8; ++c) { const float v = el[c]; if (c != e1 && v > m2) { m2 = v; e2 = c; } }
        const float x2 = __expf(m2 - m1), g1 = pg / (1.0f + x2), g2 = pg * x2 / (1.0f + x2);
        const int lp = tid * 2;
        *(LAS int*)(lds + RT_DE + lp * 4) = gi * 8 + e1; *(LAS int*)(lds + RT_DE + lp * 4 + 4) = gi * 8 + e2;
        *(LAS float*)(lds + RT_DG + lp * 4) = g1; *(LAS float*)(lds + RT_DG + lp * 4 + 4) = g2;
    }
    __syncthreads();
    if (tid < 2 * rows_per) { const int e = *(LAS int*)(lds + RT_DE + tid * 4); *(LAS int*)(lds + RT_LR + tid * 4) = __hip_atomic_fetch_add((LAS int*)(lds + RT_LC) + e, 1, __ATOMIC_RELAXED, __HIP_MEMORY_SCOPE_WORKGROUP); }
    __syncthreads();
    if (tid < 32) { const int n = *(LAS int*)(lds + RT_LC + tid * 4); *(LAS int*)(lds + RT_BS + tid * 4) = n ? (int)__hip_atomic_fetch_add(cnt + 64 * tid, (unsigned)n, RLX_AGENT) : 0; }
    __syncthreads();
    if (tid < 2 * rows_per) { const int e = *(LAS int*)(lds + RT_DE + tid * 4); const int rank = *(LAS int*)(lds + RT_BS + e * 4) + *(LAS int*)(lds + RT_LR + tid * 4);
        const int pair = F.vcu * rows_per * 2 + tid;
        pairlist[(size_t)e * PLCAP + rank] = pair; gate[pair] = *(LAS float*)(lds + RT_DG + tid * 4); }
}
__device__ __forceinline__ void moe_table(Frame& F, const unsigned* cnt, LAS int* tab) {
    __syncthreads();
    if (F.tid < 32) tab[F.tid] = (int)__hip_atomic_load(cnt + 64 * F.tid, RLX_AGENT);
    __syncthreads();
    if (F.tid < 32) { int st = 0; for (int q = 0; q < F.tid; ++q) st += (tab[q] + 255) >> 8; tab[32 + F.tid] = st; }
    __syncthreads();
}
struct MoeCv { const float* src; int nsrc; bf16* dst; int dld, row_off, kind, n0, k0; bool scaled; };
template <int MODE>
__device__ __forceinline__ MoeCv moe_cv(int it, const float* w1, const float* w3, const float* w2, bf16* W13, bf16* W2T) {
    MoeCv m; const int e = MODE == 0 ? it / 512 : it / 256, mat = MODE == 0 ? (it >> 8) & 1 : 2, li = it & 255;
    if (mat < 2) { const int kb = li >> 4, nb = li & 15; m.k0 = 64 * kb; m.n0 = 32 * nb; m.nsrc = FF; m.src = (mat == 0 ? w1 : w3) + (size_t)e * DM * FF + (size_t)m.k0 * FF + m.n0;
        m.dst = W13 + (size_t)e * 1024 * DM; m.dld = DM; m.row_off = mat * 128; m.kind = 3; m.scaled = true; }
    else { const int kb = li >> 5, nb = li & 31; m.k0 = 64 * kb; m.n0 = 32 * nb; m.nsrc = DM; m.src = w2 + (size_t)e * FF * DM + (size_t)m.k0 * DM + m.n0;
        m.dst = W2T + (size_t)e * DM * FF; m.dld = FF; m.row_off = 0; m.kind = 4; m.scaled = false; }
    return m;
}
template <int MODE>
__device__ __forceinline__ void moe_convert(Frame& F, int gw, int NGW, const float* w1, const float* w3, const float* w2, const float* gffn, bf16* W13, bf16* W2T) {
    LAS float* scr = (LAS float*)(F.lds + F.wave * 16384);
    const int lane = F.lane, rr = lane >> 3, c4 = (lane & 7) * 4;
    constexpr int NITEM = MODE == 0 ? NEXP * 512 : NEXP * 256;
    if (gw >= NITEM) return;
    f32x4 wa[8], wb[8]; MoeCv ma, mb;
#define CV_LOAD(W, M, it_) do { M = moe_cv<MODE>((it_), w1, w3, w2, W13, W2T); \
        _Pragma("unroll") for (int i = 0; i < 8; ++i) W[i] = *(const f32x4*)(M.src + (size_t)(8 * i + rr) * M.nsrc + c4); } while (0)
#define CV_PROC(W, M, nxt_) do { const MoeCv m = M; \
        _Pragma("unroll") for (int i = 0; i < 8; ++i) { const int kk = 8 * i + rr; f32x4 v = W[i]; if (m.scaled) v = v * gffn[m.k0 + kk]; \
            *(LAS f32x4*)(scr + kk * 32 + (c4 ^ (4 * i))) = v; } \
        if ((nxt_) < NITEM) CV_LOAD(W, M, (nxt_));                       \
        LDS_WAIT(); asm volatile("" ::: "memory"); \
        const int c = lane & 7; \
        _Pragma("unroll") for (int j = 0; j < 4; ++j) { const int n = (lane >> 3) + 8 * j; const LAS float* sp = scr + (8 * c) * 32 + (n ^ (4 * c)); \
            v4u o; o.x = cvt2(sp[0 * 32], sp[1 * 32]); o.y = cvt2(sp[2 * 32], sp[3 * 32]); o.z = cvt2(sp[4 * 32], sp[5 * 32]); o.w = cvt2(sp[6 * 32], sp[7 * 32]); \
            *(v4u*)(m.dst + (size_t)(m.row_off + rowmap(m.kind, m.n0 + n)) * m.dld + m.k0 + 8 * c) = o; } \
        LDS_WAIT(); asm volatile("" ::: "memory"); } while (0)
    CV_LOAD(wa, ma, gw);
    if (gw + NGW < NITEM) CV_LOAD(wb, mb, gw + NGW);
    for (int it = gw; it < NITEM; it += 2 * NGW) {
        CV_PROC(wa, ma, it + 2 * NGW);
        if (it + NGW < NITEM) CV_PROC(wb, mb, it + 3 * NGW);
    }
#undef CV_LOAD
#undef CV_PROC
}
__device__ __forceinline__ void moba_kmean(Frame& F, const bf16* K, int b, int h) {
    LAS unsigned char* lds = F.lds; const int tid = F.tid;
    LAS float* part = (LAS float*)lds;
    LAS float* km = (LAS float*)(lds + attn_body::LDS_KMEAN);
    const int c8 = tid & 7, rg = tid >> 3;
    for (int blk = 0; blk < 7; ++blk) {
        float s[8] = {0.f, 0.f, 0.f, 0.f, 0.f, 0.f, 0.f, 0.f};
#pragma unroll
        for (int rr = 0; rr < 4; ++rr) { const int row = blk * 256 + rg + 64 * rr; const v4u w = *(const v4u*)(K + ((size_t)b * SEQ + row) * DM + h * HD + 8 * c8);
            s[0] += bflo(w.x); s[1] += bfhi(w.x); s[2] += bflo(w.y); s[3] += bfhi(w.y); s[4] += bflo(w.z); s[5] += bfhi(w.z); s[6] += bflo(w.w); s[7] += bfhi(w.w); }
        *(LAS f32x4*)(part + rg * 64 + 8 * c8) = (f32x4){s[0], s[1], s[2], s[3]}; *(LAS f32x4*)(part + rg * 64 + 8 * c8 + 4) = (f32x4){s[4], s[5], s[6], s[7]};
        __syncthreads();
        if (tid < 64) { float t = 0.f; for (int q = 0; q < 64; ++q) t += part[q * 64 + tid]; km[blk * 64 + tid] = t * (1.0f / 256.0f); }
        __syncthreads();
    }
}

__device__ __forceinline__ pg8::GemmCfg mkcfg(int lda, int ldb, int K) { pg8::GemmCfg g; g.lda = lda; g.ldb = ldb; g.K = K; g.kj_tile = 1 << 30; g.kj_bytes = 0; return g; }
__device__ __forceinline__ BatchSched mkbs(int G, int c, int nb, int nM, int nN, int lda, int ldb, const void* A, const void* B, size_t strideA, size_t strideB) {
    BatchSched S; S.G = G; S.c = c; S.nb = nb; S.nM = nM; S.nN = nN; S.lda = lda; S.ldb = ldb; S.A = (const char*)A; S.B = (const char*)B; S.strideA = strideA; S.strideB = strideB; S.plain = false; return S; }
__device__ __forceinline__ EpiStore mkes(bf16* O, int ldo, size_t strideO, bool nat) { EpiStore E; E.O = O; E.ldo = ldo; E.strideO = strideO; E.nat = nat; return E; }

constexpr int N_PHASES = 20;
__global__ void __launch_bounds__(NWAVES * 64, 2) mega_fwd(Args args) {
    extern __shared__ __attribute__((aligned(16))) unsigned char lds_raw[];
    Frame F;
    F.lds = (LAS unsigned char*)lds_raw;
    F.tid = threadIdx.x; F.lane = F.tid & 63; F.wave = __builtin_amdgcn_readfirstlane(F.tid >> 6);
    F.G = gridDim.x; { const int bx = blockIdx.x; F.vcu = (F.G % 8 == 0) ? (bx % 8) * (F.G / 8) + bx / 8 : bx; }
    F.ws = args.ws;
    unsigned char* ws = args.ws;
    volatile LAS unsigned* MISC = (volatile LAS unsigned*)(F.lds + MISC_OFF);
    for (int u = F.tid; u < 128; u += NWAVES * 64) MISC[u] = 0u;
    __syncthreads();
    unsigned* ctl = (unsigned*)(ws + WS_CTL);
    XcdBarrier bar = xcd_barrier_post(ctl + CW_BAR, MISC + 8);
    const int lo = args.ph_lo, hi = args.ph_hi;
#ifndef PH_SEL
#define PH_SEL(k) true
#endif
#define IN(k) (PH_SEL(k) && lo <= (k) && (k) < hi)
#define SEAM(k) do { if (IN(k) && IN((k) + 1)) xcd_barrier(bar); } while (0)
    LAS unsigned char* ring = F.lds + RING_OFF;
    const int cblk = (int)blockIdx.x;


    if (IN(0)) p0_prologue(F, args);
    SEAM(0);
    if (IN(1)) {
        {
            const BatchSched S = mkbs(F.G, cblk, 3, NTOK / 256, 4, DM, DM, ws + ARENA(0), ws + WS_WRKV, UNIT, (size_t)DM * DM * 2);
            pg8::gemm_phase(ring, mkcfg(DM, DM, DM), S, mkes((bf16*)(ws + ARENA(3)), DM, UNIT / 2, false)); }
        {
            const BatchSched S = mkbs(F.G, (cblk + 128) & 255, 2, NMEM / 256, 4, DM, DM, ws + WS_MEMN, ws + WS_WMXK, (size_t)NMEM * DM * 2, (size_t)DM * DM * 2);
            pg8::gemm_phase(ring, mkcfg(DM, DM, DM), S, mkes((bf16*)(ws + WS_KMEM), DM, (size_t)NMEM * DM, false)); }
        {
            const BatchSched S = mkbs(F.G, (cblk + 128) & 255, 2, NMEM / 256, 4, DM, DM, ws + WS_MEMN, ws + WS_WMXV, (size_t)NMEM * DM * 2, (size_t)DM * DM * 2);
            pg8::gemm_phase(ring, mkcfg(DM, DM, DM), S, mkes((bf16*)(ws + WS_VMEM), DM, (size_t)NMEM * DM, false)); }
        LoraDownSched S2; S2.G = F.G; S2.c = cblk; S2.hp = (const char*)(ws + ARENA(6)); S2.B = (const char*)(ws + WS_WLD);
        pg8::GemmCfg g2 = mkcfg(DM, 2048, 2048); g2.kj_tile = 16; g2.kj_bytes = 4096;
        EpiLoraDown E2; E2.O = (bf16*)(ws + WS_LO);
        pg8::gemm_phase(ring, g2, S2, E2);
    }
    SEAM(1);
#ifndef SCAN_SEQ
    if (IN(3)) rwkv_scan_chunked(F, (const bf16*)(ws + ARENA(3)), (const bf16*)(ws + ARENA(4)), (const bf16*)(ws + ARENA(5)), (const bf16*)(ws + WS_LO), (const bf16*)(ws + WS_WLU), (const float*)INP(8), (const float*)INP(11), (bf16*)(ws + ARENA(6)));
#else
    if (IN(3)) rwkv_scan(F, args, (const bf16*)(ws + ARENA(3)), (const bf16*)(ws + ARENA(4)), (const bf16*)(ws + ARENA(5)), (const bf16*)(ws + ARENA(0)), (const bf16*)(ws + ARENA(1)), (const bf16*)(ws + ARENA(2)), (bf16*)(ws + ARENA(6)));
#endif
    SEAM(3);

    {
        constexpr int l = 0; constexpr int pb = 4;
        constexpr int A_MIX = l == 0 ? 6 : 1, A_TAB = 3, A_P = 2, A_W13 = 4, A_W2T = 5, A_HB = 1, A_YB = 2;
        bf16* X = (bf16*)(ws + ARENA(0));
        if (l == 1) {
            if (IN(11)) {
                const BatchSched S = mkbs(F.G, cblk, 1, NTOK / 256, 12, DM, DM, ws + ARENA(0), ws + WS_WMBQKV, 0, 0);
                EpiQKVRope E; E.Q = (bf16*)(ws + ARENA(4)); E.K = (bf16*)(ws + ARENA(5)); E.V = (bf16*)(ws + ARENA(6)); E.rope = (const f32x2*)(ws + WS_ROPE); E.rinv = (const float*)(ws + WS_RINV);
                pg8::gemm_phase(ring, mkcfg(DM, DM, DM), S, E);
            }
            SEAM(11);
            if (IN(12)) {
                const int bh = F.vcu;
                if (bh < BATCH * NHEAD) {
                    const int b = bh / NHEAD, h = bh % NHEAD;
                    moba_kmean(F, (const bf16*)(ws + ARENA(5)), b, h);
                    for (int qb = 7; qb >= 0; --qb)
                        attn_body::attn_unit<8>(b, h, qb, (const attn_body::bf16*)(ws + ARENA(4)), (const attn_body::bf16*)(ws + ARENA(5)), (const attn_body::bf16*)(ws + ARENA(6)), (attn_body::bf16*)(ws + ARENA(1)), (char*)lds_raw);
                }
            }
            SEAM(12);
        }
        if (IN(pb)) {
            { const BatchSched S = mkbs(F.G, cblk, 1, NTOK / 256, 4, DM, DM, ws + ARENA(A_MIX), ws + (l == 0 ? WS_WRWO : WS_WMBO), 0, 0);
              EpiResidual<true, l == 0> E; E.src = l == 0 ? INP(0) : (const void*)X; E.X = X; E.jobrows = 0; E.SSQ = (float*)(ws + WS_SSQ); E.xch = (LAS float*)(F.lds + EPI_OFF);
              pg8::gemm_phase(ring, mkcfg(DM, DM, DM), S, E); }
            if (l == 0) {
            { XAttnSched S; S.G = F.G; S.c = F.vcu; S.mode = 0; S.A = (const char*)(ws + WS_KMEM) + (size_t)l * NMEM * DM * 2; S.B = (const char*)(ws + WS_WMXQ) + (size_t)l * DM * DM * 2;
              pg8::gemm_phase(ring, mkcfg(DM, DM, 256), S, mkes((bf16*)(ws + ARENA(A_TAB)), DM, (size_t)MEMT * DM, true)); }
            { XAttnSched S; S.G = F.G; S.c = F.vcu; S.mode = 1; S.A = (const char*)(ws + WS_WMXO) + (size_t)l * DM * DM * 2; S.B = (const char*)(ws + WS_VMEM) + (size_t)l * NMEM * DM * 2;
              pg8::gemm_phase(ring, mkcfg(DM, DM, 256), S, mkes((bf16*)(ws + ARENA(A_TAB)) + (size_t)32 * MiB / 2, DM, (size_t)DM * DM, true)); }
            }
        }
        SEAM(pb);
        if (IN(pb + 1)) {
            XAttnSched S; S.G = F.G; S.c = F.vcu; S.mode = 2; S.A = (const char*)X; S.B = (const char*)(ws + ARENA(A_TAB));
            EpiSoftmax E; E.P = (bf16*)(ws + ARENA(A_P)); E.xch = (LAS float*)(F.lds + EPI_OFF); E.SSQ = (const float*)(ws + WS_SSQ);
            pg8::gemm_phase(ring, mkcfg(DM, DM, DM), S, E);
        }
        SEAM(pb + 1);
        if (IN(pb + 2)) {
            BatchSched S = mkbs(F.G, F.vcu, BATCH, SEQ / 256, 4, DM, DM, ws + ARENA(A_P), ws + ARENA(A_TAB) + 32 * MiB, (size_t)SEQ * DM * 2, (size_t)DM * DM * 2); S.plain = true;
            EpiResidual<false, false> E; E.src = X; E.X = X; E.jobrows = SEQ; E.SSQ = nullptr; E.xch = (LAS float*)(F.lds + EPI_OFF);
            pg8::gemm_phase(ring, mkcfg(DM, DM, DM), S, E);
        }
        SEAM(pb + 2);
        unsigned* cnt = ctl + CW_CNT + l * 32 * 64;
        int* pairlist = (int*)(ws + WS_PAIRLIST); float* gate = (float*)(ws + WS_GATE);
        if (IN(pb + 3)) {
            if (F.vcu & 1) { moe_convert<0>(F, F.vcu * NWAVES + F.wave, F.G * NWAVES, (const float*)INP(32) + (size_t)l * NEXP * DM * FF, (const float*)INP(33) + (size_t)l * NEXP * DM * FF, (const float*)INP(34) + (size_t)l * NEXP * FF * DM, (const float*)INP(6) + l * DM, (bf16*)(ws + ARENA(A_W13)), (bf16*)(ws + ARENA(A_W2T)));
                __syncthreads();
                moe_router(F, X, (const float*)INP(6) + l * DM, (const float*)INP(28) + (size_t)l * DM * 4, (const float*)INP(29) + l * 4, (const float*)INP(30) + (size_t)l * DM * 32, (const float*)INP(31) + l * 32,
                               (float*)(ws + WS_RINV), pairlist, gate, cnt); }
            else { moe_router(F, X, (const float*)INP(6) + l * DM, (const float*)INP(28) + (size_t)l * DM * 4, (const float*)INP(29) + l * 4, (const float*)INP(30) + (size_t)l * DM * 32, (const float*)INP(31) + l * 32,
                               (float*)(ws + WS_RINV), pairlist, gate, cnt);
                __syncthreads();
                moe_convert<0>(F, F.vcu * NWAVES + F.wave, F.G * NWAVES, (const float*)INP(32) + (size_t)l * NEXP * DM * FF, (const float*)INP(33) + (size_t)l * NEXP * DM * FF, (const float*)INP(34) + (size_t)l * NEXP * FF * DM, (const float*)INP(6) + l * DM, (bf16*)(ws + ARENA(A_W13)), (bf16*)(ws + ARENA(A_W2T))); }
        }
        SEAM(pb + 3);
        if (IN(pb + 4)) {
            MoeSched S; S.G = F.G; S.c = F.vcu; S.shift = 1; S.ncol = 4; S.cstep = 128; S.A = (const char*)X; S.B = (const char*)(ws + ARENA(A_W13)); S.bstride_e = (size_t)1024 * DM * 2; S.bstride_n = (size_t)256 * DM * 2; S.pairlist = pairlist; S.tab = (LAS int*)(F.lds + EPI_OFF + 8192); moe_table(F, cnt, (LAS int*)(F.lds + EPI_OFF + 8192));
            EpiMoE1 E; E.H = (bf16*)(ws + ARENA(A_HB)); E.pairlist = pairlist; E.rinv = (const float*)(ws + WS_RINV);
            pg8::gemm_phase(ring, mkcfg(DM, DM, DM), S, E);
            {
                const int nun = 4 * (S.tab[63] + ((S.tab[31] + 255) >> 8)), rem = nun % F.G;
                if (rem == 0 || F.vcu >= rem)
                    moe_convert<1>(F, (rem ? F.vcu - rem : F.vcu) * NWAVES + F.wave, (rem ? F.G - rem : F.G) * NWAVES, (const float*)INP(32) + (size_t)l * NEXP * DM * FF, (const float*)INP(33) + (size_t)l * NEXP * DM * FF, (const float*)INP(34) + (size_t)l * NEXP * FF * DM, (const float*)INP(6) + l * DM, (bf16*)(ws + ARENA(A_W13)), (bf16*)(ws + ARENA(A_W2T)));
            }
        }
        SEAM(pb + 4);
        if (IN(pb + 5)) {
            MoeSched S; S.G = F.G; S.c = cblk; S.shift = 0; S.ncol = 4; S.cstep = 256; S.A = (const char*)(ws + ARENA(A_HB)); S.B = (const char*)(ws + ARENA(A_W2T)); S.bstride_e = (size_t)DM * FF * 2; S.bstride_n = (size_t)256 * FF * 2; S.pairlist = pairlist; S.tab = (LAS int*)(F.lds + EPI_OFF + 8192); moe_table(F, cnt, (LAS int*)(F.lds + EPI_OFF + 8192));
            EpiMoE2 E; E.Y = (unsigned char*)(ws + ARENA(A_YB)); E.pairlist = pairlist; E.gate = gate;
            pg8::gemm_phase(ring, mkcfg(FF, FF, FF), S, E);
        }
        SEAM(pb + 5);
        if (IN(pb + 6)) {
            if (l == 0 && (F.vcu & 1)) {
                { XAttnSched S; S.G = F.G; S.c = F.vcu; S.mode = 0; S.A = (const char*)(ws + WS_KMEM) + (size_t)1 * NMEM * DM * 2; S.B = (const char*)(ws + WS_WMXQ) + (size_t)1 * DM * DM * 2;
                  pg8::gemm_phase(ring, mkcfg(DM, DM, 256), S, mkes((bf16*)(ws + ARENA(A_TAB)), DM, (size_t)MEMT * DM, true)); }
                { XAttnSched S; S.G = F.G; S.c = F.vcu; S.mode = 1; S.A = (const char*)(ws + WS_WMXO) + (size_t)1 * DM * DM * 2; S.B = (const char*)(ws + WS_VMEM) + (size_t)1 * NMEM * DM * 2;
                  pg8::gemm_phase(ring, mkcfg(DM, DM, 256), S, mkes((bf16*)(ws + ARENA(A_TAB)) + (size_t)32 * MiB / 2, DM, (size_t)DM * DM, true)); }
            }
            combine_rows(F, X, (const unsigned char*)(ws + ARENA(A_YB)), l == 0 ? (const float*)INP(3) + DM : (const float*)INP(35), (float*)(ws + WS_RINV), args.out, l == 1);
            if (l == 0 && !(F.vcu & 1)) {
                { XAttnSched S; S.G = F.G; S.c = F.vcu; S.mode = 0; S.A = (const char*)(ws + WS_KMEM) + (size_t)1 * NMEM * DM * 2; S.B = (const char*)(ws + WS_WMXQ) + (size_t)1 * DM * DM * 2;
                  pg8::gemm_phase(ring, mkcfg(DM, DM, 256), S, mkes((bf16*)(ws + ARENA(A_TAB)), DM, (size_t)MEMT * DM, true)); }
                { XAttnSched S; S.G = F.G; S.c = F.vcu; S.mode = 1; S.A = (const char*)(ws + WS_WMXO) + (size_t)1 * DM * DM * 2; S.B = (const char*)(ws + WS_VMEM) + (size_t)1 * NMEM * DM * 2;
                  pg8::gemm_phase(ring, mkcfg(DM, DM, 256), S, mkes((bf16*)(ws + ARENA(A_TAB)) + (size_t)32 * MiB / 2, DM, (size_t)DM * DM, true)); }
            }
        }
        if (l == 0) SEAM(pb + 6);
    }
    {
        constexpr int l = 1; constexpr int pb = 13;
        constexpr int A_MIX = l == 0 ? 6 : 1, A_TAB = 3, A_P = 2, A_W13 = 4, A_W2T = 5, A_HB = 1, A_YB = 2;
        bf16* X = (bf16*)(ws + ARENA(0));
        if (l == 1) {
            if (IN(11)) {
                const BatchSched S = mkbs(F.G, cblk, 1, NTOK / 256, 12, DM, DM, ws + ARENA(0), ws + WS_WMBQKV, 0, 0);
                EpiQKVRope E; E.Q = (bf16*)(ws + ARENA(4)); E.K = (bf16*)(ws + ARENA(5)); E.V = (bf16*)(ws + ARENA(6)); E.rope = (const f32x2*)(ws + WS_ROPE); E.rinv = (const float*)(ws + WS_RINV);
                pg8::gemm_phase(ring, mkcfg(DM, DM, DM), S, E);
            }
            SEAM(11);
            if (IN(12)) {
                const int bh = F.vcu;
                if (bh < BATCH * NHEAD) {
                    const int b = bh / NHEAD, h = bh % NHEAD;
                    moba_kmean(F, (const bf16*)(ws + ARENA(5)), b, h);
                    for (int qb = 7; qb >= 0; --qb)
                        attn_body::attn_unit<8>(b, h, qb, (const attn_body::bf16*)(ws + ARENA(4)), (const attn_body::bf16*)(ws + ARENA(5)), (const attn_body::bf16*)(ws + ARENA(6)), (attn_body::bf16*)(ws + ARENA(1)), (char*)lds_raw);
                }
            }
            SEAM(12);
        }
        if (IN(pb)) {
            { const BatchSched S = mkbs(F.G, cblk, 1, NTOK / 256, 4, DM, DM, ws + ARENA(A_MIX), ws + (l == 0 ? WS_WRWO : WS_WMBO), 0, 0);
              EpiResidual<true, l == 0> E; E.src = l == 0 ? INP(0) : (const void*)X; E.X = X; E.jobrows = 0; E.SSQ = (float*)(ws + WS_SSQ); E.xch = (LAS float*)(F.lds + EPI_OFF);
              pg8::gemm_phase(ring, mkcfg(DM, DM, DM), S, E); }
            if (l == 0) {
            { XAttnSched S; S.G = F.G; S.c = F.vcu; S.mode = 0; S.A = (const char*)(ws + WS_KMEM) + (size_t)l * NMEM * DM * 2; S.B = (const char*)(ws + WS_WMXQ) + (size_t)l * DM * DM * 2;
              pg8::gemm_phase(ring, mkcfg(DM, DM, 256), S, mkes((bf16*)(ws + ARENA(A_TAB)), DM, (size_t)MEMT * DM, true)); }
            { XAttnSched S; S.G = F.G; S.c = F.vcu; S.mode = 1; S.A = (const char*)(ws + WS_WMXO) + (size_t)l * DM * DM * 2; S.B = (const char*)(ws + WS_VMEM) + (size_t)l * NMEM * DM * 2;
              pg8::gemm_phase(ring, mkcfg(DM, DM, 256), S, mkes((bf16*)(ws + ARENA(A_TAB)) + (size_t)32 * MiB / 2, DM, (size_t)DM * DM, true)); }
            }
        }
        SEAM(pb);
        if (IN(pb + 1)) {
            XAttnSched S; S.G = F.G; S.c = F.vcu; S.mode = 2; S.A = (const char*)X; S.B = (const char*)(ws + ARENA(A_TAB));
            EpiSoftmax E; E.P = (bf16*)(ws + ARENA(A_P)); E.xch = (LAS float*)(F.lds + EPI_OFF); E.SSQ = (const float*)(ws + WS_SSQ);
            pg8::gemm_phase(ring, mkcfg(DM, DM, DM), S, E);
        }
        SEAM(pb + 1);
        if (IN(pb + 2)) {
            BatchSched S = mkbs(F.G, F.vcu, BATCH, SEQ / 256, 4, DM, DM, ws + ARENA(A_P), ws + ARENA(A_TAB) + 32 * MiB, (size_t)SEQ * DM * 2, (size_t)DM * DM * 2); S.plain = true;
            EpiResidual<false, false> E; E.src = X; E.X = X; E.jobrows = SEQ; E.SSQ = nullptr; E.xch = (LAS float*)(F.lds + EPI_OFF);
            pg8::gemm_phase(ring, mkcfg(DM, DM, DM), S, E);
        }
        SEAM(pb + 2);
        unsigned* cnt = ctl + CW_CNT + l * 32 * 64;
        int* pairlist = (int*)(ws + WS_PAIRLIST); float* gate = (float*)(ws + WS_GATE);
        if (IN(pb + 3)) {
            if (F.vcu & 1) { moe_convert<0>(F, F.vcu * NWAVES + F.wave, F.G * NWAVES, (const float*)INP(32) + (size_t)l * NEXP * DM * FF, (const float*)INP(33) + (size_t)l * NEXP * DM * FF, (const float*)INP(34) + (size_t)l * NEXP * FF * DM, (const float*)INP(6) + l * DM, (bf16*)(ws + ARENA(A_W13)), (bf16*)(ws + ARENA(A_W2T)));
                __syncthreads();
                moe_router(F, X, (const float*)INP(6) + l * DM, (const float*)INP(28) + (size_t)l * DM * 4, (const float*)INP(29) + l * 4, (const float*)INP(30) + (size_t)l * DM * 32, (const float*)INP(31) + l * 32,
                               (float*)(ws + WS_RINV), pairlist, gate, cnt); }
            else { moe_router(F, X, (const float*)INP(6) + l * DM, (const float*)INP(28) + (size_t)l * DM * 4, (const float*)INP(29) + l * 4, (const float*)INP(30) + (size_t)l * DM * 32, (const float*)INP(31) + l * 32,
                               (float*)(ws + WS_RINV), pairlist, gate, cnt);
                __syncthreads();
                moe_convert<0>(F, F.vcu * NWAVES + F.wave, F.G * NWAVES, (const float*)INP(32) + (size_t)l * NEXP * DM * FF, (const float*)INP(33) + (size_t)l * NEXP * DM * FF, (const float*)INP(34) + (size_t)l * NEXP * FF * DM, (const float*)INP(6) + l * DM, (bf16*)(ws + ARENA(A_W13)), (bf16*)(ws + ARENA(A_W2T))); }
        }
        SEAM(pb + 3);
        if (IN(pb + 4)) {
            MoeSched S; S.G = F.G; S.c = F.vcu; S.shift = 1; S.ncol = 4; S.cstep = 128; S.A = (const char*)X; S.B = (const char*)(ws + ARENA(A_W13)); S.bstride_e = (size_t)1024 * DM * 2; S.bstride_n = (size_t)256 * DM * 2; S.pairlist = pairlist; S.tab = (LAS int*)(F.lds + EPI_OFF + 8192); moe_table(F, cnt, (LAS int*)(F.lds + EPI_OFF + 8192));
            EpiMoE1 E; E.H = (bf16*)(ws + ARENA(A_HB)); E.pairlist = pairlist; E.rinv = (const float*)(ws + WS_RINV);
            pg8::gemm_phase(ring, mkcfg(DM, DM, DM), S, E);
            {
                const int nun = 4 * (S.tab[63] + ((S.tab[31] + 255) >> 8)), rem = nun % F.G;
                if (rem == 0 || F.vcu >= rem)
                    moe_convert<1>(F, (rem ? F.vcu - rem : F.vcu) * NWAVES + F.wave, (rem ? F.G - rem : F.G) * NWAVES, (const float*)INP(32) + (size_t)l * NEXP * DM * FF, (const float*)INP(33) + (size_t)l * NEXP * DM * FF, (const float*)INP(34) + (size_t)l * NEXP * FF * DM, (const float*)INP(6) + l * DM, (bf16*)(ws + ARENA(A_W13)), (bf16*)(ws + ARENA(A_W2T)));
            }
        }
        SEAM(pb + 4);
        if (IN(pb + 5)) {
            MoeSched S; S.G = F.G; S.c = cblk; S.shift = 0; S.ncol = 4; S.cstep = 256; S.A = (const char*)(ws + ARENA(A_HB)); S.B = (const char*)(ws + ARENA(A_W2T)); S.bstride_e = (size_t)DM * FF * 2; S.bstride_n = (size_t)256 * FF * 2; S.pairlist = pairlist; S.tab = (LAS int*)(F.lds + EPI_OFF + 8192); moe_table(F, cnt, (LAS int*)(F.lds + EPI_OFF + 8192));
            EpiMoE2 E; E.Y = (unsigned char*)(ws + ARENA(A_YB)); E.pairlist = pairlist; E.gate = gate;
            pg8::gemm_phase(ring, mkcfg(FF, FF, FF), S, E);
        }
        SEAM(pb + 5);
        if (IN(pb + 6)) {
            if (l == 0 && (F.vcu & 1)) {
                { XAttnSched S; S.G = F.G; S.c = F.vcu; S.mode = 0; S.A = (const char*)(ws + WS_KMEM) + (size_t)1 * NMEM * DM * 2; S.B = (const char*)(ws + WS_WMXQ) + (size_t)1 * DM * DM * 2;
                  pg8::gemm_phase(ring, mkcfg(DM, DM, 256), S, mkes((bf16*)(ws + ARENA(A_TAB)), DM, (size_t)MEMT * DM, true)); }
                { XAttnSched S; S.G = F.G; S.c = F.vcu; S.mode = 1; S.A = (const char*)(ws + WS_WMXO) + (size_t)1 * DM * DM * 2; S.B = (const char*)(ws + WS_VMEM) + (size_t)1 * NMEM * DM * 2;
                  pg8::gemm_phase(ring, mkcfg(DM, DM, 256), S, mkes((bf16*)(ws + ARENA(A_TAB)) + (size_t)32 * MiB / 2, DM, (size_t)DM * DM, true)); }
            }
            combine_rows(F, X, (const unsigned char*)(ws + ARENA(A_YB)), l == 0 ? (const float*)INP(3) + DM : (const float*)INP(35), (float*)(ws + WS_RINV), args.out, l == 1);
            if (l == 0 && !(F.vcu & 1)) {
                { XAttnSched S; S.G = F.G; S.c = F.vcu; S.mode = 0; S.A = (const char*)(ws + WS_KMEM) + (size_t)1 * NMEM * DM * 2; S.B = (const char*)(ws + WS_WMXQ) + (size_t)1 * DM * DM * 2;
                  pg8::gemm_phase(ring, mkcfg(DM, DM, 256), S, mkes((bf16*)(ws + ARENA(A_TAB)), DM, (size_t)MEMT * DM, true)); }
                { XAttnSched S; S.G = F.G; S.c = F.vcu; S.mode = 1; S.A = (const char*)(ws + WS_WMXO) + (size_t)1 * DM * DM * 2; S.B = (const char*)(ws + WS_VMEM) + (size_t)1 * NMEM * DM * 2;
                  pg8::gemm_phase(ring, mkcfg(DM, DM, 256), S, mkes((bf16*)(ws + ARENA(A_TAB)) + (size_t)32 * MiB / 2, DM, (size_t)DM * DM, true)); }
            }
        }
        if (l == 0) SEAM(pb + 6);
    }
#undef IN
#undef SEAM
}

extern "C" void kernel_launch(void* const* d_in, const int* in_sizes, int n_in, void* d_out, int out_size, void* d_ws, size_t ws_size, hipStream_t stream) {
    static int grid = 0;
    if (grid == 0) {
        if (n_in != 36 || in_sizes[0] != NTOK * DM || out_size != NTOK * DM || ws_size < WS_END) { fprintf(stderr, "kernel_launch: unexpected problem (n_in %d, in0 %d, out %d, ws %zu < %zu); nothing launched\n", n_in, n_in > 0 ? in_sizes[0] : -1, out_size, ws_size, (size_t)WS_END); grid = -1; return; }
        int dev = 0, cus = 0, per_cu = 0;
        if (hipGetDevice(&dev) != hipSuccess || hipDeviceGetAttribute(&cus, hipDeviceAttributeMultiprocessorCount, dev) != hipSuccess) { grid = -1; return; }
        if (hipFuncSetAttribute((const void*)mega_fwd, hipFuncAttributeMaxDynamicSharedMemorySize, LDS_BYTES) != hipSuccess) { fprintf(stderr, "kernel_launch: hipFuncSetAttribute failed\n"); grid = -1; return; }
        if (hipOccupancyMaxActiveBlocksPerMultiprocessor(&per_cu, (const void*)mega_fwd, NWAVES * 64, LDS_BYTES) != hipSuccess || per_cu < 1) fprintf(stderr, "kernel_launch: occupancy query reports %d\n", per_cu);
        (void)hipGetLastError();
        grid = cus;
        if (grid != 256) { fprintf(stderr, "kernel_launch: built for 256 CUs, device has %d; nothing launched\n", grid); grid = -1; return; }
    }
    if (grid < 0) return;
    if (hipMemsetAsync((char*)d_ws + WS_CTL, 0, CTL_ZERO_BYTES, stream) != hipSuccess) return;
    Args a{};
    for (int i = 0; i < 36; ++i) a.in[i] = d_in[i];
    a.out = (float*)d_out; a.ws = (unsigned char*)d_ws; a.ph_lo = 0; a.ph_hi = N_PHASES;
#if defined(REP_LO) && defined(REP_HI)
    a.ph_hi = REP_HI;
    hipLaunchKernelGGL(mega_fwd, dim3(grid), dim3(NWAVES * 64), LDS_BYTES, stream, a);
#ifdef REP_ZERO_ALL
    (void)hipMemsetAsync((char*)d_ws + WS_CTL, 0, CTL_ZERO_BYTES, stream);
#else
    (void)hipMemsetAsync((char*)d_ws + WS_CTL + (size_t)CW_BAR * 4, 0, (size_t)XCD_BAR_WORDS * 4, stream);
#endif
    a.ph_lo = REP_LO; a.ph_hi = N_PHASES;
#endif
    hipLaunchKernelGGL(mega_fwd, dim3(grid), dim3(NWAVES * 64), LDS_BYTES, stream, a);
}
```
